# Optimizing an MI355X kernel written in HIP

```python
import math
import jax
import jax.numpy as jnp
from jax import lax
import numpy as np

D_MODEL = 1024
BATCH = 32
SEQ = 256
DEPTH = 4
DEC_BATCH = 8
DEC_SEQ = 2048
PAST_LEN = 512

GRID_W = 64
N_HEADS = 16
HEAD_DIM = D_MODEL // N_HEADS
N_KV_A = 16
N_KV_GQA = 4
D_FF = 4 * D_MODEL
N_MIXERS = 3
Q_BLOCK = 128
WINDOW = 128
WIN_H = 8
WIN_W = 16
NA_QCOLS = 16
NA_KCOLS = 32
ROPE_BASE = 10000.0
EPS = 1e-6
NEG_INF = -1e30
ADA_CHUNKS = 6

kernel_name = 'hybrid_diffusion_prefix_step'


def rmsnorm(x, g):
    xf = x.astype(jnp.float32)
    y = xf * lax.rsqrt(jnp.mean(xf * xf, axis=-1, keepdims=True) + EPS)
    return (y * g.astype(jnp.float32)).astype(x.dtype)


def rope_1d(x, pos):
    half = x.shape[-1] // 2
    freqs = jnp.exp(-math.log(ROPE_BASE) * jnp.arange(half, dtype=jnp.float32) / half)
    ang = pos[:, None] * freqs[None, :]
    shape = (x.shape[1],) + (1,) * (x.ndim - 3) + (half,)
    cos = jnp.cos(ang).reshape(shape).astype(x.dtype)
    sin = jnp.sin(ang).reshape(shape).astype(x.dtype)
    x1, x2 = x[..., :half], x[..., half:]
    return jnp.concatenate([x1 * cos - x2 * sin, x2 * cos + x1 * sin], axis=-1)


def rope_2d(x):
    t = jnp.arange(x.shape[1])
    rows = (t // GRID_W).astype(jnp.float32)
    cols = (t % GRID_W).astype(jnp.float32)
    half = x.shape[-1] // 2
    return jnp.concatenate([rope_1d(x[..., :half], rows), rope_1d(x[..., half:], cols)], axis=-1)


def split_qkv(qkv, n_kv):
    b_, t_ = qkv.shape[:2]
    nq = N_HEADS * HEAD_DIM
    nk = n_kv * HEAD_DIM
    q = qkv[..., :nq].reshape(b_, t_, n_kv, N_HEADS // n_kv, HEAD_DIM)
    k = qkv[..., nq:nq + nk].reshape(b_, t_, n_kv, HEAD_DIM)
    v = qkv[..., nq + nk:].reshape(b_, t_, n_kv, HEAD_DIM)
    return q, k, v


def attend(q, k, v, mask=None, sink=None):
    s = jnp.einsum('bqhgd,bkhd->bhgqk', q, k).astype(jnp.float32) * (HEAD_DIM ** -0.5)
    if mask is not None:
        s = jnp.where(mask, s, NEG_INF)
    if sink is not None:
        col = jnp.broadcast_to(sink.astype(jnp.float32)[None, :, :, None, None], s.shape[:-1] + (1,))
        p = jax.nn.softmax(jnp.concatenate([s, col], axis=-1), axis=-1)[..., :-1]
    else:
        p = jax.nn.softmax(s, axis=-1)
    return jnp.einsum('bhgqk,bkhd->bqhgd', p.astype(v.dtype), v)


def dense_blocked(q, k, v, sink=None):
    b_, t_ = q.shape[:2]
    nb = t_ // Q_BLOCK
    qb = jnp.moveaxis(q.reshape((b_, nb, Q_BLOCK) + q.shape[2:]), 1, 0)
    ob = lax.map(lambda blk: attend(blk, k, v, sink=sink), qb)
    return jnp.moveaxis(ob, 0, 1).reshape(q.shape)


def windowed_sink_attention(q, k, v, k_ctx, v_ctx, sink):
    b_, t_ = q.shape[:2]
    nb = t_ // Q_BLOCK
    n_ctx = k_ctx.shape[1]
    pad = ((0, 0), (Q_BLOCK, Q_BLOCK), (0, 0), (0, 0))
    kp, vp = jnp.pad(k, pad), jnp.pad(v, pad)
    qb = jnp.moveaxis(q.reshape((b_, nb, Q_BLOCK) + q.shape[2:]), 1, 0)
    ctx_mask = jnp.ones((Q_BLOCK, n_ctx), dtype=bool)

    def blk(args):
        i, q_blk = args
        start = i * Q_BLOCK
        k_band = lax.dynamic_slice_in_dim(kp, start, 3 * Q_BLOCK, axis=1)
        v_band = lax.dynamic_slice_in_dim(vp, start, 3 * Q_BLOCK, axis=1)
        qpos = start + jnp.arange(Q_BLOCK)
        kpos = start - Q_BLOCK + jnp.arange(3 * Q_BLOCK)
        valid = ((kpos >= 0) & (kpos < t_))[None, :] & (jnp.abs(qpos[:, None] - kpos[None, :]) <= WINDOW)
        mask = jnp.concatenate([valid, ctx_mask], axis=1)
        return attend(q_blk, jnp.concatenate([k_band, k_ctx], axis=1),
                      jnp.concatenate([v_band, v_ctx], axis=1), mask=mask, sink=sink)

    ob = lax.map(blk, (jnp.arange(nb), qb))
    return jnp.moveaxis(ob, 0, 1).reshape(q.shape)


def neighbourhood_attention(q, k, v, k_ctx, v_ctx, rpb):
    b_, t_, h_, d_ = q.shape
    rows = t_ // GRID_W
    kh = min(WIN_H, rows)
    ncb = GRID_W // NA_QCOLS
    scale = HEAD_DIM ** -0.5
    qc = np.arange(GRID_W).reshape(ncb, NA_QCOLS)
    band0 = np.clip(np.arange(ncb) * NA_QCOLS - WIN_W // 2, 0, GRID_W - NA_KCOLS)
    kc = band0[:, None] + np.arange(NA_KCOLS)
    c0 = np.clip(qc - WIN_W // 2, 0, GRID_W - WIN_W)
    col_valid = (kc[:, None, :] >= c0[:, :, None]) & (kc[:, None, :] < c0[:, :, None] + WIN_W)
    col_idx = np.clip(kc[:, None, :] - qc[:, :, None] + WIN_W - 1, 0, 2 * WIN_W - 2)
    loc_mask = jnp.asarray(col_valid)[:, :, None, :]
    rpb_c = rpb[:, :, col_idx]
    kg = k.reshape(b_, rows, GRID_W, h_, d_)
    vg = v.reshape(b_, rows, GRID_W, h_, d_)
    qrows = jnp.moveaxis(q.reshape(b_, rows, GRID_W, h_, d_), 1, 0).reshape(rows, b_, ncb, NA_QCOLS, h_, d_)
    n_loc = kh * NA_KCOLS

    def row(args):
        r, q_r = args
        r0 = jnp.clip(r - kh // 2, 0, rows - kh)
        kb = jnp.take(lax.dynamic_slice_in_dim(kg, r0, kh, axis=1), kc, axis=2)
        vb = jnp.take(lax.dynamic_slice_in_dim(vg, r0, kh, axis=1), kc, axis=2)
        row_idx = r0 + jnp.arange(kh) - r + WIN_H - 1
        bias = jnp.transpose(jnp.take(rpb_c, row_idx, axis=1), (0, 2, 3, 1, 4))
        s_loc = jnp.einsum('bnqhd,binchd->bhnqic', q_r, kb).astype(jnp.float32) * scale + bias.astype(jnp.float32)
        s_loc = jnp.where(loc_mask, s_loc, NEG_INF).reshape(b_, h_, ncb, NA_QCOLS, n_loc)
        s_ctx = jnp.einsum('bnqhd,bkhd->bhnqk', q_r, k_ctx).astype(jnp.float32) * scale
        p = jax.nn.softmax(jnp.concatenate([s_loc, s_ctx], axis=-1), axis=-1).astype(v.dtype)
        p_loc = p[..., :n_loc].reshape(b_, h_, ncb, NA_QCOLS, kh, NA_KCOLS)
        o = (jnp.einsum('bhnqic,binchd->bnqhd', p_loc, vb)
             + jnp.einsum('bhnqk,bkhd->bnqhd', p[..., n_loc:], v_ctx))
        return o.reshape(b_, GRID_W, h_, d_)

    o = lax.map(row, (jnp.arange(rows), qrows))
    return jnp.moveaxis(o, 0, 1).reshape(b_, t_, h_, d_)


def sublayers(x, cond, l, mix, ada_w, ada_b, norm_mix_g, norm_mlp_g, w_o, mlp_w1, mlp_b1, mlp_w2, mlp_b2):
    mods = jnp.split(jax.nn.silu(cond) @ ada_w[l] + ada_b[l], ADA_CHUNKS, axis=-1)
    sh_a, sc_a, g_a, sh_f, sc_f, g_f = [m_[:, None, :] for m_ in mods]
    h = rmsnorm(x, norm_mix_g[l]) * (1 + sc_a) + sh_a
    o, kv = mix(h)
    x = x + g_a * (o.reshape(x.shape) @ w_o[l])
    h = rmsnorm(x, norm_mlp_g[l]) * (1 + sc_f) + sh_f
    x = x + g_f * (jnp.square(jax.nn.relu(h @ mlp_w1[l] + mlp_b1[l])) @ mlp_w2[l] + mlp_b2[l])
    return x, kv


def setup_inputs(seed: int = 0) -> dict:
    key = jax.random.key(seed)
    ks = iter(jax.random.split(key, 32))

    def nrm(shape, s):
        return s * jax.random.normal(next(ks), shape, jnp.float32)

    n_a, n_b, n_c = (len(range(m, DEPTH, N_MIXERS)) for m in range(N_MIXERS))
    qkv_a = (N_HEADS + 2 * N_KV_A) * HEAD_DIM
    qkv_g = (N_HEADS + 2 * N_KV_GQA) * HEAD_DIM
    fan = D_MODEL ** -0.5
    return {
        'x_prompt': nrm((BATCH, SEQ, D_MODEL), 1.0),
        'x_sample': nrm((DEC_BATCH, DEC_SEQ, D_MODEL), 1.0),
        'cache_k_a': nrm((DEC_BATCH, n_a, PAST_LEN, N_KV_A, HEAD_DIM), 1.0),
        'cache_v_a': nrm((DEC_BATCH, n_a, PAST_LEN, N_KV_A, HEAD_DIM), 1.0),
        'cache_k_b': nrm((DEC_BATCH, n_b, PAST_LEN, N_KV_GQA, HEAD_DIM), 1.0),
        'cache_v_b': nrm((DEC_BATCH, n_b, PAST_LEN, N_KV_GQA, HEAD_DIM), 1.0),
        'cache_k_c': nrm((DEC_BATCH, n_c, PAST_LEN, N_KV_GQA, HEAD_DIM), 1.0),
        'cache_v_c': nrm((DEC_BATCH, n_c, PAST_LEN, N_KV_GQA, HEAD_DIM), 1.0),
        'c': nrm((DEC_BATCH, D_MODEL), 1.0),
        'c_ctx': nrm((D_MODEL,), 1.0),
        'ada_w': nrm((DEPTH, D_MODEL, ADA_CHUNKS * D_MODEL), 0.5 * fan),
        'ada_b': nrm((DEPTH, ADA_CHUNKS * D_MODEL), 0.01),
        'norm_mix_g': 1.0 + nrm((DEPTH, D_MODEL), 0.01),
        'norm_mlp_g': 1.0 + nrm((DEPTH, D_MODEL), 0.01),
        'w_o': nrm((DEPTH, D_MODEL, D_MODEL), fan),
        'mlp_w1': nrm((DEPTH, D_MODEL, D_FF), fan),
        'mlp_b1': nrm((DEPTH, D_FF), 0.01),
        'mlp_w2': nrm((DEPTH, D_FF, D_MODEL), D_FF ** -0.5),
        'mlp_b2': nrm((DEPTH, D_MODEL), 0.01),
        'w_qkv_a': nrm((n_a, D_MODEL, qkv_a), fan),
        'rpb_a': nrm((n_a, N_HEADS, 2 * WIN_H - 1, 2 * WIN_W - 1), 0.1),
        'w_qkv_b': nrm((n_b, D_MODEL, qkv_g), fan),
        'sink_b': nrm((n_b, N_HEADS), 0.5),
        'w_qkv_c': nrm((n_c, D_MODEL, qkv_g), fan),
        'q_norm_c': 1.0 + nrm((n_c, HEAD_DIM), 0.01),
        'k_norm_c': 1.0 + nrm((n_c, HEAD_DIM), 0.01),
        'final_norm_g': 1.0 + nrm((D_MODEL,), 0.01),
    }


def reference(x_prompt, x_sample, cache_k_a, cache_v_a, cache_k_b, cache_v_b, cache_k_c, cache_v_c,
              c, c_ctx, ada_w, ada_b, norm_mix_g, norm_mlp_g, w_o, mlp_w1, mlp_b1, mlp_w2, mlp_b2,
              w_qkv_a, rpb_a, w_qkv_b, sink_b, w_qkv_c, q_norm_c, k_norm_c, final_norm_g):
    w_qkv = (w_qkv_a, w_qkv_b, w_qkv_c)
    n_kv = (N_KV_A, N_KV_GQA, N_KV_GQA)
    caches_k = (cache_k_a, cache_k_b, cache_k_c)
    caches_v = (cache_v_a, cache_v_b, cache_v_c)
    new_k = ([], [], [])
    new_v = ([], [], [])
    shared = (ada_w, ada_b, norm_mix_g, norm_mlp_g, w_o, mlp_w1, mlp_b1, mlp_w2, mlp_b2)
    xp, xs = x_prompt, x_sample
    cond_ctx = c_ctx[None, :]

    for l in range(DEPTH):
        m, j = l % N_MIXERS, l // N_MIXERS
        sink = sink_b[j].reshape(N_KV_GQA, N_HEADS // N_KV_GQA) if m == 1 else None

        def ctx_mix(h):
            q, k, v = split_qkv(h @ w_qkv[m][j], n_kv[m])
            if m == 2:
                q, k = rmsnorm(q, q_norm_c[j]), rmsnorm(k, k_norm_c[j])
            return dense_blocked(q, k, v, sink=sink), (k, v)

        xp, (k_new, v_new) = sublayers(xp, cond_ctx, l, ctx_mix, *shared)
        new_k[m].append(k_new)
        new_v[m].append(v_new)

        def lat_mix(h):
            q, k, v = split_qkv(h @ w_qkv[m][j], n_kv[m])
            k_ctx, v_ctx = caches_k[m][:, j], caches_v[m][:, j]
            if m == 0:
                o = neighbourhood_attention(q[:, :, :, 0], k, v, k_ctx, v_ctx, rpb_a[j])
            elif m == 1:
                o = windowed_sink_attention(rope_2d(q), rope_2d(k), v, k_ctx, v_ctx, sink)
            else:
                q = rope_2d(rmsnorm(q, q_norm_c[j]))
                k = rope_2d(rmsnorm(k, k_norm_c[j]))
                o = dense_blocked(q, jnp.concatenate([k, k_ctx], axis=1), jnp.concatenate([v, v_ctx], axis=1))
            return o, None

        xs, _ = sublayers(xs, c, l, lat_mix, *shared)

    y_prompt = rmsnorm(xp, final_norm_g)
    y_sample = rmsnorm(xs, final_norm_g)
    k_a = jnp.stack(new_k[0], axis=1)
    v_a = jnp.stack(new_v[0], axis=1)
    k_b = jnp.stack(new_k[1], axis=1)
    v_b = jnp.stack(new_v[1], axis=1)
    k_c = jnp.stack(new_k[2], axis=1)
    v_c = jnp.stack(new_v[2], axis=1)
    return (y_prompt, y_sample, k_a, v_a, k_b, v_b, k_c, v_c)
```

```cpp
#include <hip/hip_runtime.h>
#include <hip/hip_cooperative_groups.h>
#include <cstdio>
#include <cstdint>
namespace cg = cooperative_groups;

__device__ __forceinline__ int opaque_tid() { int t = threadIdx.x; asm volatile("" : "+v"(t)); return t; }
__device__ __forceinline__ int opaque_bid() { int b = blockIdx.x; asm volatile("" : "+s"(b)); return b; }
namespace pg8 {
#define PG8_LAS __attribute__((address_space(3)))
typedef unsigned short bf16_t;
typedef short bf16x8 __attribute__((ext_vector_type(8)));
typedef float f32x4 __attribute__((ext_vector_type(4)));
typedef unsigned u32x4 __attribute__((ext_vector_type(4)));
constexpr int BM = 256, BK = 64, HALF = 128, HTB = HALF * BK * 2  , STAGE_BYTES = 8 * HTB, NXCD = 8, WGM = 8;

__host__ __device__ __forceinline__ int lds_byte(int r, int c) { const int st = (r >> 4) * 2 + (c >> 5), rr = r & 15, cc = c & 31, ob = rr * 64 + cc * 2; return st * 1024 + (ob ^ (((ob >> 9) & 1) << 5)); }
__host__ __device__ __forceinline__ void stage_rc(int b, int& R, int& C) { const int st = b / 1024, sb = b % 1024, swz = sb ^ (((sb >> 9) & 1) << 5); R = (st >> 1) * 16 + swz / 64; C = (st & 1) * 32 + (swz % 64) / 2; }
__host__ __device__ __forceinline__ int perm32(int rho) { const int n = rho >> 4, i = rho & 15; return 8 * (i >> 2) + 4 * n + (i & 3); }

struct Unit { int pm, pn; };
struct Gemm { const bf16_t* A; const bf16_t* Bt; int M, N, K; };

struct StaticOrder {
    int nM, nN, nwg, G, c, lim;
    __host__ __device__ void init(int M, int N, int G_, int c_) { nM = M / BM; nN = N / BM; nwg = nM * nN; G = G_; c = c_; lim = nwg; }
    __host__ __device__ __forceinline__ void map(int L, Unit& u) const {
        int wgid = L; { const int q = nwg / NXCD, r = nwg % NXCD, xcd = wgid % NXCD, off = wgid / NXCD; wgid = (xcd < r ? xcd * (q + 1) : r * (q + 1) + (xcd - r) * q) + off; }
        const int nig = WGM * nN, gid = wgid / nig, fm = gid * WGM, gsz = (nM - fm) < WGM ? (nM - fm) : WGM;
        u.pm = fm + ((wgid % nig) % gsz); u.pn = (wgid % nig) / gsz;
    }
    __host__ __device__ bool next(int i, Unit& u) const {
        const long L = (long)i * G + c; if (L >= lim) return false;
        map((int)L, u); return true;
    }
    __device__ __forceinline__ void a_ready(const Unit&) const {}
    __device__ __forceinline__ void done(const Unit&) const {}
};
struct OneUnit {
    Unit u;
    __host__ __device__ bool next(int i, Unit& v) const { if (i != 0) return false; v = u; return true; }
    __device__ __forceinline__ void a_ready(const Unit&) const {}
    __device__ __forceinline__ void done(const Unit&) const {}
};

__device__ __forceinline__ unsigned cvt_pk_bf16(float lo, float hi) { unsigned r; asm volatile("v_cvt_pk_bf16_f32 %0, %1, %2" : "=v"(r) : "v"(lo), "v"(hi)); return r; }
typedef float f32x2 __attribute__((ext_vector_type(2)));
typedef unsigned u32x2 __attribute__((ext_vector_type(2)));
__device__ __forceinline__ int cond_of_row(int row) { return row < 8192 ? 8 : ((row - 8192) >> 11); }

struct EpiQKV {
    static constexpr bool PERM = true, AFTER_DRAIN = false;
    bf16_t* O; int ldc; int nk;
    float* kout; float* vout; int nj, j;
    const float* rowsq; const float* shw;
    int halfm, rowoff;
    __device__ __forceinline__ void operator()(const f32x4 (&acc)[2][2][4][2], const Unit& u, int wr, int wc, int fr, int fq) const {
        const int row0 = u.pm * BM + rowoff + wr * 64 + fr; const int colt = u.pn * BM;
        const int col0 = colt + wc * 32 + 8 * fq;
        float* fout = nullptr; int fc0 = 0;
        if (u.pm < 32 && colt >= 1024) { if (colt - 1024 < nk) { fout = kout; fc0 = col0 - 1024; } else { fout = vout; fc0 = col0 - 1024 - nk; } }
        const float* sw = shw + (size_t)cond_of_row(u.pm * BM) * ldc + col0;
        f32x4 bv[2][2];
#pragma unroll
        for (int bj = 0; bj < 2; ++bj)
#pragma unroll
            for (int n = 0; n < 2; ++n) bv[bj][n] = *(const f32x4*)(sw + bj * HALF + 4 * n);
#pragma unroll
        for (int ai = 0; ai < 2; ++ai) { if (halfm && ai == 1) break;
#pragma unroll
            for (int m = 0; m < 4; ++m) { const int row = row0 + ai * HALF + m * 16; bf16_t* rowp = O + (size_t)row * ldc + col0;
                const float rstd = rsqrtf(rowsq[row] * (1.f / 1024.f) + 1e-6f);
                float* frow = fout ? fout + ((size_t)((row >> 8) * nj + j) * 256 + (row & 255)) * nk + fc0 : nullptr;
#pragma unroll
                for (int bj = 0; bj < 2; ++bj) { const f32x4 v0 = acc[ai][bj][m][0] * rstd + bv[bj][0], v1 = acc[ai][bj][m][1] * rstd + bv[bj][1];
                    u32x4 w; w.x = cvt_pk_bf16(v0[0], v0[1]); w.y = cvt_pk_bf16(v0[2], v0[3]); w.z = cvt_pk_bf16(v1[0], v1[1]); w.w = cvt_pk_bf16(v1[2], v1[3]);
                    *(u32x4*)(rowp + bj * HALF) = w;
                    if (fout) { __builtin_nontemporal_store(v0, (f32x4*)(frow + bj * HALF)); __builtin_nontemporal_store(v1, (f32x4*)(frow + bj * HALF + 4)); } } } }
    }
};
struct EpiSqRelu {
    static constexpr bool PERM = true, AFTER_DRAIN = false;
    bf16_t* O; int ldc; const float* rowsq; const float* shw;
    __device__ __forceinline__ void operator()(const f32x4 (&acc)[2][2][4][2], const Unit& u, int wr, int wc, int fr, int fq) const {
        const int row0 = u.pm * BM + wr * 64 + fr; const int col0 = u.pn * BM + wc * 32 + 8 * fq;
        const float* sw = shw + (size_t)cond_of_row(u.pm * BM) * ldc + col0;
        f32x4 bv[2][2];
#pragma unroll
        for (int bj = 0; bj < 2; ++bj)
#pragma unroll
            for (int n = 0; n < 2; ++n) bv[bj][n] = *(const f32x4*)(sw + bj * HALF + 4 * n);
#pragma unroll
        for (int ai = 0; ai < 2; ++ai)
#pragma unroll
            for (int m = 0; m < 4; ++m) { const int row = row0 + ai * HALF + m * 16; bf16_t* rowp = O + (size_t)row * ldc + col0;
                const float rstd = rsqrtf(rowsq[row] * (1.f / 1024.f) + 1e-6f);
#pragma unroll
                for (int bj = 0; bj < 2; ++bj) { f32x4 v0 = acc[ai][bj][m][0] * rstd + bv[bj][0], v1 = acc[ai][bj][m][1] * rstd + bv[bj][1];
#pragma unroll
                    for (int e = 0; e < 4; ++e) { const float a = fmaxf(v0[e], 0.f), b = fmaxf(v1[e], 0.f); v0[e] = a * a; v1[e] = b * b; }
                    u32x4 w; w.x = cvt_pk_bf16(v0[0], v0[1]); w.y = cvt_pk_bf16(v0[2], v0[3]); w.z = cvt_pk_bf16(v1[0], v1[1]); w.w = cvt_pk_bf16(v1[2], v1[3]);
                    __builtin_nontemporal_store(w, (u32x4*)(rowp + bj * HALF)); } }
    }
};
struct EpiResGate {
    static constexpr bool PERM = true, AFTER_DRAIN = false;
    bf16_t* X; const float* gate; const float* bias; float* rsq; bf16_t* Hn; const float* ng; const float* nsc; int halfm, rowoff;
    __device__ __forceinline__ void operator()(const f32x4 (&acc)[2][2][4][2], const Unit& u, int wr, int wc, int fr, int fq) const {
        const int row0 = u.pm * BM + rowoff + wr * 64 + fr; const int col0 = u.pn * BM + wc * 32 + 8 * fq;
        const int cond = cond_of_row(u.pm * BM);
        const float* g = gate + (size_t)cond * 6144;
        f32x4 gv[2][2], bv[2][2], gm[2][2];
#pragma unroll
        for (int bj = 0; bj < 2; ++bj)
#pragma unroll
            for (int n = 0; n < 2; ++n) { gv[bj][n] = *(const f32x4*)(g + col0 + bj * HALF + n * 4);
                bv[bj][n] = bias ? *(const f32x4*)(bias + col0 + bj * HALF + n * 4) : (f32x4){0.f, 0.f, 0.f, 0.f};
                if (Hn) { const f32x4 a = *(const f32x4*)(ng + col0 + bj * HALF + n * 4), c = *(const f32x4*)(nsc + (size_t)cond * 6144 + col0 + bj * HALF + n * 4); gm[bj][n] = a * (c + 1.f); }
                else gm[bj][n] = (f32x4){0.f, 0.f, 0.f, 0.f}; }
#pragma unroll
        for (int ai = 0; ai < 2; ++ai) { if (halfm && ai == 1) break;
#pragma unroll
            for (int m = 0; m < 4; ++m) { const int row = row0 + ai * HALF + m * 16; bf16_t* rowp = X + (size_t)row * 1024 + col0; float ss = 0.f;
#pragma unroll
                for (int bj = 0; bj < 2; ++bj) { u32x4* p = (u32x4*)(rowp + bj * HALF); const u32x4 xb = *p;
                    const f32x4 xo0 = (f32x4){__builtin_bit_cast(float, xb.x << 16), __builtin_bit_cast(float, xb.x & 0xffff0000u), __builtin_bit_cast(float, xb.y << 16), __builtin_bit_cast(float, xb.y & 0xffff0000u)};
                    const f32x4 xo1 = (f32x4){__builtin_bit_cast(float, xb.z << 16), __builtin_bit_cast(float, xb.z & 0xffff0000u), __builtin_bit_cast(float, xb.w << 16), __builtin_bit_cast(float, xb.w & 0xffff0000u)};
                    const f32x4 xn0 = xo0 + gv[bj][0] * (acc[ai][bj][m][0] + bv[bj][0]), xn1 = xo1 + gv[bj][1] * (acc[ai][bj][m][1] + bv[bj][1]);
                    { u32x4 xw; xw.x = cvt_pk_bf16(xn0[0], xn0[1]); xw.y = cvt_pk_bf16(xn0[2], xn0[3]); xw.z = cvt_pk_bf16(xn1[0], xn1[1]); xw.w = cvt_pk_bf16(xn1[2], xn1[3]); *p = xw; }
                    ss += ((xn0[0] * xn0[0] + xn0[1] * xn0[1]) + (xn0[2] * xn0[2] + xn0[3] * xn0[3])) + ((xn1[0] * xn1[0] + xn1[1] * xn1[1]) + (xn1[2] * xn1[2] + xn1[3] * xn1[3]));
                    if (Hn) { const f32x4 h0 = xn0 * gm[bj][0], h1 = xn1 * gm[bj][1]; u32x4 w; w.x = cvt_pk_bf16(h0[0], h0[1]); w.y = cvt_pk_bf16(h0[2], h0[3]); w.z = cvt_pk_bf16(h1[0], h1[1]); w.w = cvt_pk_bf16(h1[2], h1[3]);
                        *(u32x4*)(Hn + (size_t)row * 1024 + col0 + bj * HALF) = w; } }
                ss += __shfl_xor(ss, 16); ss += __shfl_xor(ss, 32);
                if (fq == 0) unsafeAtomicAdd(rsq + row, ss); } }
    }
};

template <class Epi, class Sched, bool ALIGN_EPI = false, bool SP2 = false, bool HALFM = false>
__device__ __forceinline__ void gemm_phase(PG8_LAS unsigned char* lds, const Gemm g, const Sched& S, const Epi& E) {
    const int tid = opaque_tid(), wid = __builtin_amdgcn_readfirstlane(tid >> 6), lane = tid & 63, wr = wid >> 2, wc = wid & 3, fr = lane & 15, fq = lane >> 4;
    const int K = g.K, nt = K / BK;
    unsigned voffA[2], voffB[2];
#pragma unroll
    for (int i = 0; i < 2; ++i) { int R, C; stage_rc(tid * 16 + i * 8192, R, C); const int Rb = Epi::PERM ? ((R & ~31) + perm32(R & 31)) : R;
        voffA[i] = (unsigned)(R * K + C) * 2u; voffB[i] = (unsigned)(Rb * K + C) * 2u; }
    const size_t kstep = (size_t)(BK * 2);
    const size_t hstep = (size_t)HALF * K * 2;
    const size_t tstep = 2 * hstep;
    const unsigned ldsw = (unsigned)wid * 1024u;
    const int aoff = lds_byte(wr * 64 + fr, fq * 8), boff = lds_byte(wc * 32 + fr, fq * 8);
#define PG8_SA(b, h) (((b) * 2 + (h)) * HTB)
#define PG8_SB(b, h) ((4 + (b) * 2 + (h)) * HTB)
#define PG8_STAGE(bufoff, gbase, voff) do { _Pragma("unroll") for (int _i = 0; _i < 2; ++_i) \
        __builtin_amdgcn_global_load_lds((const unsigned*)((const char*)(gbase) + (voff)[_i]), (PG8_LAS unsigned*)(lds + (bufoff) + ldsw + _i * 8192), 16, 0, 0); } while (0)
#define PG8_LDA(dst, b, h) do { _Pragma("unroll") for (int m = 0; m < 4; ++m) _Pragma("unroll") for (int k = 0; k < 2; ++k) dst[m][k] = *(const PG8_LAS bf16x8*)(lds + PG8_SA(b, h) + aoff + m * 2048 + k * 1024); } while (0)
#define PG8_LDB(dst, b, h) do { _Pragma("unroll") for (int n = 0; n < 2; ++n) _Pragma("unroll") for (int k = 0; k < 2; ++k) dst[n][k] = *(const PG8_LAS bf16x8*)(lds + PG8_SB(b, h) + boff + n * 2048 + k * 1024); } while (0)
#define PG8_MMA(ai, bj, At, Bt) do { __builtin_amdgcn_s_setprio(1); _Pragma("unroll") for (int m = 0; m < 4; ++m) _Pragma("unroll") for (int n = 0; n < 2; ++n) _Pragma("unroll") for (int k = 0; k < 2; ++k) \
        acc[ai][bj][m][n] = __builtin_amdgcn_mfma_f32_16x16x32_bf16(Bt[n][k], At[m][k], acc[ai][bj][m][n], 0, 0, 0); __builtin_amdgcn_s_setprio(0); } while (0)
#define PG8_WAIT_V(n) asm volatile("s_waitcnt vmcnt(" #n ")" ::: "memory")
#define PG8_WAIT_L(n) asm volatile("s_waitcnt lgkmcnt(" #n ")" ::: "memory")
#define PG8_BAR __builtin_amdgcn_s_barrier()
#define PG8_SCHED __builtin_amdgcn_sched_barrier(0)
    Unit cur, nxt; int ui = 0;
    if (!S.next(0, cur)) return;
    f32x4 acc[2][2][4][2];
#pragma unroll
    for (int a = 0; a < 2; ++a)
#pragma unroll
        for (int b = 0; b < 2; ++b)
#pragma unroll
            for (int m = 0; m < 4; ++m)
#pragma unroll
                for (int n = 0; n < 2; ++n) acc[a][b][m][n] = (f32x4){0.f, 0.f, 0.f, 0.f};
    bf16x8 At[4][2], B0[2][2], B1[2][2];
    const char* cA = (const char*)g.A + (size_t)cur.pm * tstep; const char* cB = (const char*)g.Bt + (size_t)cur.pn * tstep;
    S.a_ready(cur);
    if constexpr (SP2) {
        PG8_STAGE(PG8_SB(0, 0), cB, voffB); PG8_STAGE(PG8_SB(0, 1), cB + hstep, voffB); PG8_STAGE(PG8_SA(0, 0), cA, voffA); PG8_STAGE(PG8_SA(0, 1), cA + hstep, voffA);
        if (wr == 1) PG8_BAR;
        PG8_WAIT_V(2); PG8_BAR;
        PG8_STAGE(PG8_SB(1, 0), cB + kstep, voffB); PG8_STAGE(PG8_SA(1, 0), cA + kstep, voffA); PG8_STAGE(PG8_SB(1, 1), cB + hstep + kstep, voffB);
        PG8_WAIT_V(6); PG8_BAR;
    } else {
        PG8_STAGE(PG8_SB(0, 0), cB, voffB); PG8_STAGE(PG8_SA(0, 0), cA, voffA); PG8_STAGE(PG8_SB(0, 1), cB + hstep, voffB); PG8_STAGE(PG8_SA(0, 1), cA + hstep, voffA);
        if (wr == 1) PG8_BAR;
        PG8_WAIT_V(4); PG8_BAR;
        PG8_STAGE(PG8_SB(1, 0), cB + kstep, voffB); PG8_STAGE(PG8_SA(1, 0), cA + kstep, voffA); PG8_STAGE(PG8_SB(1, 1), cB + hstep + kstep, voffB);
        PG8_WAIT_V(6); PG8_BAR;
    }
    for (;;) {
        const bool has_next = S.next(ui + 1, nxt);
        const char* nA = has_next ? (const char*)g.A + (size_t)nxt.pm * tstep : cA; const char* nB = has_next ? (const char*)g.Bt + (size_t)nxt.pn * tstep : cB;
        for (int t = 0; t < nt; t += 2) {
            const bool last = (t == nt - 2);
            const char* a1 = cA + (size_t)(t + 1) * kstep;
            const char* a2 = last ? nA : cA + (size_t)(t + 2) * kstep; const char* b2 = last ? nB : cB + (size_t)(t + 2) * kstep;
            const char* a3 = a2 + kstep; const char* b3 = b2 + kstep;
            if (last && has_next) S.a_ready(nxt);
            if constexpr (SP2) {
            PG8_LDB(B0, 0, 0); PG8_LDB(B1, 0, 1); PG8_SCHED; PG8_LDA(At, 0, 0); PG8_STAGE(PG8_SA(1, 1), a1 + hstep, voffA);
            PG8_WAIT_V(8); PG8_WAIT_L(0); PG8_BAR; PG8_MMA(0, 0, At, B0); PG8_MMA(0, 1, At, B1); PG8_BAR; PG8_SCHED;
            if constexpr (!HALFM) { PG8_LDA(At, 0, 1); } PG8_STAGE(PG8_SB(0, 0), b2, voffB); PG8_STAGE(PG8_SB(0, 1), b2 + hstep, voffB); PG8_STAGE(PG8_SA(0, 0), a2, voffA);
            PG8_WAIT_V(8); PG8_WAIT_L(0); PG8_BAR; if constexpr (!HALFM) { PG8_MMA(1, 0, At, B0); PG8_MMA(1, 1, At, B1); } PG8_BAR; PG8_SCHED;
            PG8_LDB(B0, 1, 0); PG8_LDB(B1, 1, 1); PG8_SCHED; PG8_LDA(At, 1, 0); PG8_STAGE(PG8_SA(0, 1), a2 + hstep, voffA);
            PG8_WAIT_V(8); PG8_WAIT_L(0); PG8_BAR; PG8_MMA(0, 0, At, B0); PG8_MMA(0, 1, At, B1); PG8_BAR; PG8_SCHED;
            if constexpr (!HALFM) { PG8_LDA(At, 1, 1); } PG8_STAGE(PG8_SB(1, 0), b3, voffB); PG8_STAGE(PG8_SB(1, 1), b3 + hstep, voffB); PG8_STAGE(PG8_SA(1, 0), a3, voffA);
            PG8_WAIT_V(8); PG8_WAIT_L(0); PG8_BAR; if constexpr (!HALFM) { PG8_MMA(1, 0, At, B0); PG8_MMA(1, 1, At, B1); } PG8_BAR; PG8_SCHED;
            } else {
            PG8_LDB(B0, 0, 0); PG8_SCHED; PG8_LDA(At, 0, 0); PG8_STAGE(PG8_SA(1, 1), a1 + hstep, voffA);
            PG8_WAIT_L(8); PG8_BAR; PG8_WAIT_L(0); PG8_MMA(0, 0, At, B0); PG8_BAR; PG8_SCHED;
            PG8_LDB(B1, 0, 1); PG8_STAGE(PG8_SB(0, 0), b2, voffB);
            PG8_BAR; PG8_WAIT_L(0); PG8_MMA(0, 1, At, B1); PG8_BAR;
            PG8_LDA(At, 0, 1); PG8_STAGE(PG8_SA(0, 0), a2, voffA);
            PG8_BAR; PG8_WAIT_L(0); PG8_MMA(1, 0, At, B0); PG8_BAR; PG8_SCHED;
            PG8_STAGE(PG8_SB(0, 1), b2 + hstep, voffB);
            PG8_WAIT_V(6); PG8_BAR; PG8_MMA(1, 1, At, B1); PG8_BAR;
            PG8_LDB(B0, 1, 0); PG8_SCHED; PG8_LDA(At, 1, 0); PG8_STAGE(PG8_SA(0, 1), a2 + hstep, voffA);
            PG8_WAIT_L(8); PG8_BAR; PG8_WAIT_L(0); PG8_MMA(0, 0, At, B0); PG8_BAR; PG8_SCHED;
            PG8_LDB(B1, 1, 1); PG8_STAGE(PG8_SB(1, 0), b3, voffB);
            PG8_BAR; PG8_WAIT_L(0); PG8_MMA(0, 1, At, B1); PG8_BAR;
            PG8_LDA(At, 1, 1); PG8_STAGE(PG8_SA(1, 0), a3, voffA);
            PG8_BAR; PG8_WAIT_L(0); PG8_MMA(1, 0, At, B0); PG8_BAR; PG8_SCHED;
            PG8_STAGE(PG8_SB(1, 1), b3 + hstep, voffB);
            PG8_WAIT_V(6); PG8_BAR; PG8_MMA(1, 1, At, B1); PG8_BAR;
            }
        }
        if constexpr (ALIGN_EPI) { if (wr == 0) PG8_BAR; }
        if constexpr (!Epi::AFTER_DRAIN) { E(acc, cur, wr, wc, fr, fq); S.done(cur); }
        if (!has_next) break;
#pragma unroll
        for (int a = 0; a < 2; ++a)
#pragma unroll
            for (int b = 0; b < 2; ++b)
#pragma unroll
                for (int m = 0; m < 4; ++m)
#pragma unroll
                    for (int n = 0; n < 2; ++n) acc[a][b][m][n] = (f32x4){0.f, 0.f, 0.f, 0.f};
        cur = nxt; cA = nA; cB = nB; ++ui;
        if constexpr (ALIGN_EPI) { if (wr == 1) PG8_BAR; }
    }
    PG8_WAIT_V(0);
    if constexpr (!ALIGN_EPI) { if (wr == 0) PG8_BAR; }
    PG8_BAR;
    if constexpr (Epi::AFTER_DRAIN) { E.fused(acc, cur, wr, wc, fr, fq, lds, wid, lane); S.done(cur); }
#undef PG8_SA
#undef PG8_SB
#undef PG8_STAGE
#undef PG8_LDA
#undef PG8_LDB
#undef PG8_MMA
#undef PG8_WAIT_V
#undef PG8_WAIT_L
#undef PG8_BAR
#undef PG8_SCHED
}
}

#define LAS __attribute__((address_space(3)))
typedef unsigned short bf16_t;
typedef short bf16x8 __attribute__((ext_vector_type(8)));
typedef short s16x4 __attribute__((ext_vector_type(4)));
typedef float f32x4 __attribute__((ext_vector_type(4)));
typedef float f32x16 __attribute__((ext_vector_type(16)));
typedef unsigned u32x4 __attribute__((ext_vector_type(4)));
typedef unsigned u32x2 __attribute__((ext_vector_type(2)));

constexpr int NTOK = 24576, NCTX = 8192, DM = 1024, DFF = 4096;
constexpr float LOG2E = 1.4426950408889634f;
constexpr float RMS_EPS = 1e-6f;
constexpr size_t MiB = 1024 * 1024;
constexpr size_t WS_MODS = 0, WS_WO = 1 * MiB, WS_W1 = 9 * MiB, WS_W2 = 41 * MiB, WS_QKVA = 73 * MiB, WS_QKVB = 85 * MiB, WS_QKVC = 88 * MiB;
constexpr size_t WS_CKA = 91 * MiB, WS_CVA = 107 * MiB, WS_CKB = 123 * MiB, WS_CVB = 125 * MiB, WS_CKC = 127 * MiB, WS_CVC = 129 * MiB;
constexpr size_t WS_H = 131 * MiB, WS_QKV = 179 * MiB, WS_O = 323 * MiB, WS_U = WS_QKV, WS_ROWSQ = 371 * MiB, WS_SHW = 372 * MiB, WS_X = 374 * MiB, WS_END = 422 * MiB;
constexpr size_t OUT_X = 0, OUT_KA = 25165824, OUT_VA = 41943040, OUT_KB = 58720256, OUT_VB = 60817408, OUT_KC = 62914560, OUT_VC = 65011712;
constexpr int LDS_BYTES = 131072 + 4096;
#ifndef REP_P0
#define REP_P0 1
#endif
#ifndef REP_NORM
#define REP_NORM 1
#endif
#ifndef REP_GEMM
#define REP_GEMM 1
#endif
#ifndef REP_SYNC
#define REP_SYNC 1
#endif
#ifndef REP_ATTN
#define REP_ATTN 1
#endif

__device__ __forceinline__ unsigned f2bf(float f) { unsigned u = __builtin_bit_cast(unsigned, f); return (u + 0x7fffu + ((u >> 16) & 1u)) >> 16; }
__device__ __forceinline__ unsigned pk2(float lo, float hi) { return f2bf(lo) | (f2bf(hi) << 16); }
__device__ __forceinline__ float bf2f(unsigned short b) { return __builtin_bit_cast(float, (unsigned)b << 16); }
__device__ __forceinline__ float wave_sum(float v) {
#pragma unroll
    for (int o = 1; o < 64; o <<= 1) v += __shfl_xor(v, o);
    return v;
}

struct Params { const float* in[27]; float* out; unsigned char* ws; int ph_lo, ph_hi; };

#define XB_TMO      128
#define XB_XCNT(j)  (256  + 64 * (j))
#define XB_XSUB(j)  (1280 + 64 * (j))
#define XB_XGEN(j)  (2304 + 64 * (j))
#define XB_TOP      3328
#define XB_TOPGEN   3392
#define XCD_BAR_WORDS 3456
#define XB_SPIN_CAP (1u << 18)

__device__ __forceinline__ unsigned xb_ld(unsigned* p)              { return __hip_atomic_load(p, __ATOMIC_RELAXED, __HIP_MEMORY_SCOPE_AGENT); }
__device__ __forceinline__ unsigned xb_add(unsigned* p, unsigned v) { return __hip_atomic_fetch_add(p, v, __ATOMIC_RELAXED, __HIP_MEMORY_SCOPE_AGENT); }
__device__ __forceinline__ unsigned xb_xcc_id() { return (unsigned)__builtin_amdgcn_s_getreg((3 << 11) | 20) & 0xFu; }
#define XB_SPIN(cond, bar) do { unsigned _sp = 0; while (cond) { __builtin_amdgcn_s_sleep(1); \
    if ((++_sp & 255u) == 0u) { if (xb_ld(&(bar)[XB_TMO])) break; if (_sp > XB_SPIN_CAP) { atomicAdd(&(bar)[XB_TMO], 1u); break; } } } } while (0)

struct XcdBarrier {
    unsigned* bar; unsigned x;
    volatile LAS unsigned* st;
};

__device__ __forceinline__ XcdBarrier xcd_barrier_post(unsigned* bar, volatile LAS unsigned* st) {
    XcdBarrier b; b.bar = bar; b.x = xb_xcc_id(); b.st = st;
    if (threadIdx.x == 0) (void)xb_add(&bar[XB_XCNT(b.x)], 1u);
    return b;
}
__device__ __forceinline__ void xcd_barrier_complete(unsigned* bar, unsigned x, unsigned& nloc, unsigned& nx) {
    const unsigned G = gridDim.x * gridDim.y * gridDim.z;
    unsigned sum, cnt, mine, sp = 0u;
    for (;;) {
        sum = 0u; cnt = 0u; mine = 0u;
#pragma unroll
        for (unsigned j = 0; j < 16; ++j) { const unsigned c = xb_ld(&bar[XB_XCNT(j)]); sum += c; cnt += (c > 0u) ? 1u : 0u; mine = (j == x) ? c : mine; }
        if (sum == G) break;
        __builtin_amdgcn_s_sleep(1);
        if ((++sp & 255u) == 0u) { if (xb_ld(&bar[XB_TMO])) break; if (sp > XB_SPIN_CAP) { atomicAdd(&bar[XB_TMO], 1u); break; } }
    }
    nloc = mine > 0u ? mine : 1u; nx = cnt > 0u ? cnt : 1u;
}

__device__ __forceinline__ void xcd_barrier(const XcdBarrier& b) {
    asm volatile("s_waitcnt vmcnt(0)" ::: "memory");
    __syncthreads();
    if (threadIdx.x == 0) {
        unsigned* bar = b.bar;
        __builtin_amdgcn_s_waitcnt(0);
        unsigned nloc = b.st[0], nx = b.st[1];
        if (nloc == 0u) { xcd_barrier_complete(bar, b.x, nloc, nx); b.st[0] = nloc; b.st[1] = nx; }
        const unsigned old = xb_add(&bar[XB_XSUB(b.x)], 1u);
        const unsigned gen = old / nloc;
        if (old + 1u == (gen + 1u) * nloc) {
            __builtin_amdgcn_fence(__ATOMIC_RELEASE, "agent");
            asm volatile("s_waitcnt vmcnt(0)" ::: "memory");
            const unsigned og = xb_add(&bar[XB_TOP], 1u);
            const unsigned tg = og / nx;
            if (og + 1u == (tg + 1u) * nx) xb_add(&bar[XB_TOPGEN], 1u);
            else XB_SPIN(xb_ld(&bar[XB_TOPGEN]) == tg, bar);
            __builtin_amdgcn_fence(__ATOMIC_ACQUIRE, "agent");
            xb_add(&bar[XB_XGEN(b.x)], 1u);
            asm volatile("s_waitcnt vmcnt(0)" ::: "memory");
        } else {
            XB_SPIN(xb_ld(&bar[XB_XGEN(b.x)]) == gen, bar);
            __builtin_amdgcn_fence(__ATOMIC_ACQUIRE, "agent");
            asm volatile("s_waitcnt vmcnt(0)" ::: "memory");
        }
    }
    __syncthreads();
}

constexpr size_t WS_BAR = 917504;

__device__ __forceinline__ void transpose_item(const float* W, int K, int N, bf16_t* WT, LAS float* scr, int item, int lane) {
    const int nblk = N / 32, kb = item / nblk, nb = item % nblk, k0 = 64 * kb, n0 = 32 * nb;
    { f32x4 v[8];
#pragma unroll
      for (int i = 0; i < 8; ++i) v[i] = *(const f32x4*)(W + (size_t)(k0 + 8 * i + (lane >> 3)) * N + n0 + 4 * (lane & 7));
#pragma unroll
      for (int i = 0; i < 8; ++i) { LAS float* d = scr + (8 * i + (lane >> 3)) * 33 + 4 * (lane & 7); d[0] = v[i][0]; d[1] = v[i][1]; d[2] = v[i][2]; d[3] = v[i][3]; } }
    asm volatile("s_waitcnt lgkmcnt(0)" ::: "memory");
    const int c = lane & 7;
#pragma unroll
    for (int j = 0; j < 4; ++j) { const int n = (lane >> 3) + 8 * j; const LAS float* s = scr + (8 * c) * 33 + n;
        u32x4 o; o.x = pk2(s[0 * 33], s[1 * 33]); o.y = pk2(s[2 * 33], s[3 * 33]); o.z = pk2(s[4 * 33], s[5 * 33]); o.w = pk2(s[6 * 33], s[7 * 33]);
        *(u32x4*)(WT + (size_t)(n0 + n) * K + k0 + 8 * c) = o; }
    asm volatile("s_waitcnt lgkmcnt(0)" ::: "memory");
}
__device__ __forceinline__ void transpose_matrix(const float* W, int K, int N, bf16_t* WT, LAS float* scr, int gw, int ngw, int lane) {
    const int items = (K / 64) * (N / 32);
    for (int it = gw; it < items; it += ngw) transpose_item(W, K, N, WT, scr, it, lane);
}
__device__ __forceinline__ void convert_array(const float* src, bf16_t* dst, size_t n4, size_t gt, size_t ngt) {
    for (size_t i = gt; i < n4; i += ngt) { const f32x4 v = ((const f32x4*)src)[i]; u32x2 o; o.x = pk2(v[0], v[1]); o.y = pk2(v[2], v[3]); ((u32x2*)dst)[i] = o; }
}

__device__ __forceinline__ void gemv9_item(const LAS float* sc, LAS float* part, const float* W, int ldw, const float* bias, float* out, int ldo, int n0, int tid) {
    const int n = n0 + (tid & 127), kq = tid >> 7;
    const float* Wp = W + (size_t)(kq * 256) * ldw + n;
    float acc[9];
#pragma unroll
    for (int c = 0; c < 9; ++c) acc[c] = 0.f;
    for (int k0 = 0; k0 < 256; k0 += 16) {
        float w[16];
#pragma unroll
        for (int i = 0; i < 16; ++i) w[i] = Wp[(size_t)(k0 + i) * ldw];
#pragma unroll
        for (int i = 0; i < 16; ++i)
#pragma unroll
            for (int c = 0; c < 9; ++c) acc[c] += sc[c * 1024 + kq * 256 + k0 + i] * w[i];
    }
#pragma unroll
    for (int c = 0; c < 9; ++c) part[(kq * 128 + (tid & 127)) * 9 + c] = acc[c];
    __syncthreads();
    if (kq == 0) {
        const float bz = bias ? bias[n] : 0.f;
#pragma unroll
        for (int c = 0; c < 9; ++c) { const float v = part[(0 * 128 + tid) * 9 + c] + part[(1 * 128 + tid) * 9 + c] + part[(2 * 128 + tid) * 9 + c] + part[(3 * 128 + tid) * 9 + c];
            out[(size_t)c * ldo + n] = v + bz; }
    }
    __syncthreads();
}
typedef const __attribute__((address_space(4))) Params* KP;
__device__ __forceinline__ void mods_phase(KP Pq, LAS unsigned char* lds) {
    const float* const in8 = Pq->in[8]; const float* const in9 = Pq->in[9]; const float* const in10 = Pq->in[10]; const float* const in11 = Pq->in[11]; unsigned char* const wsb = Pq->ws;
    LAS float* sc = (LAS float*)lds; LAS float* part = (LAS float*)(lds + 36864);
    const int tid = opaque_tid(); const int bid = opaque_bid();
    if (bid >= 192) return;
    for (int i = tid; i < 9 * 1024; i += 512) { const float v = i < 8192 ? in8[i] : in9[i - 8192]; sc[i] = v / (1.f + __expf(-v)); }
    __syncthreads();
    const int l = bid / 48, n0 = (bid % 48) * 128;
    gemv9_item(sc, part, in10 + (size_t)l * 1024 * 6144, 6144, in11 + l * 6144, (float*)(wsb + WS_MODS) + (size_t)l * 9 * 6144, 6144, n0, tid);
}
__device__ __forceinline__ void shw_phase(KP Pq, LAS unsigned char* lds) {
    LAS float* sc = (LAS float*)lds; LAS float* part = (LAS float*)(lds + 36864);
    const int tid = opaque_tid(); const int bid = opaque_bid();
    if (bid >= 200) return;
    int it = bid, l = 0;
    for (;;) { const int cnt = ((l % 3) == 0 ? 24 : 12) + 32; if (it < cnt) break; it -= cnt; ++l; }
    const int mix = l % 3, j = l / 3, nq = (mix == 0 ? 24 : 12);
    const bool isq = it < nq; const int n0 = (isq ? it : it - nq) * 128;
    const float* mods = (const float*)(Pq->ws + WS_MODS) + (size_t)l * 9 * 6144 + (isq ? 0 : 3 * 1024);
    for (int i = tid; i < 9 * 1024; i += 512) sc[i] = mods[(size_t)(i >> 10) * 6144 + (i & 1023)];
    __syncthreads();
    float* out = (float*)(Pq->ws + WS_SHW) + (size_t)(2 * l + (isq ? 0 : 1)) * 9 * 4096;
    if (isq) { const int nqkv = mix == 0 ? 3072 : 1536; const float* W = mix == 0 ? Pq->in[19] + (size_t)j * 1024 * 3072 : (mix == 1 ? Pq->in[21] : Pq->in[23]);
        gemv9_item(sc, part, W, nqkv, nullptr, out, nqkv, n0, tid); }
    else gemv9_item(sc, part, Pq->in[15] + (size_t)l * 1024 * 4096, 4096, Pq->in[16] + l * 4096, out, 4096, n0, tid);
}

__device__ __forceinline__ void xin_phase(const float* xp, const float* xs, bf16_t* X, bf16_t* H, float* rowsq0, const float* g, const float* mods0) {
    const int tid_ = opaque_tid(); const int lane = tid_ & 63, gw = opaque_bid() * 8 + (tid_ >> 6), ngw = gridDim.x * 8;
    f32x4 gv[4];
#pragma unroll
    for (int j = 0; j < 4; ++j) gv[j] = ((const f32x4*)g)[lane + 64 * j];
    for (int row = gw; row < NTOK; row += ngw) {
        const f32x4* xr = (const f32x4*)(row < NCTX ? xp + (size_t)row * DM : xs + (size_t)(row - NCTX) * DM) + lane;
        f32x4 v[4]; float s = 0.f;
#pragma unroll
        for (int j = 0; j < 4; ++j) { v[j] = xr[64 * j]; s += (v[j][0] * v[j][0] + v[j][1] * v[j][1]) + (v[j][2] * v[j][2] + v[j][3] * v[j][3]); }
        s = wave_sum(s);
        if (lane == 0) rowsq0[row] = s;
        const float* mc = mods0 + (size_t)pg8::cond_of_row(row) * 6144 + 1024;
        u32x2* xo = (u32x2*)(X + (size_t)row * DM) + lane; u32x2* o8 = (u32x2*)(H + (size_t)row * DM) + lane;
#pragma unroll
        for (int j = 0; j < 4; ++j) { const f32x4 sc = ((const f32x4*)mc)[lane + 64 * j]; const f32x4 y = v[j] * gv[j] * (sc + 1.f);
            u32x2 xb; xb.x = pk2(v[j][0], v[j][1]); xb.y = pk2(v[j][2], v[j][3]); xo[64 * j] = xb; u32x2 o; o.x = pk2(y[0], y[1]); o.y = pk2(y[2], y[3]); o8[64 * j] = o; }
    }
}

__device__ __forceinline__ void norm_mod_phase(const float* X, bf16_t* H, const float* g, const float* mods_l, int ch_sh, int ch_sc) {
    const int tid_ = opaque_tid(); const int lane = tid_ & 63, gw = opaque_bid() * 8 + (tid_ >> 6), ngw = gridDim.x * 8;
    f32x4 gv[4];
#pragma unroll
    for (int j = 0; j < 4; ++j) gv[j] = ((const f32x4*)g)[lane + 64 * j];
    for (int row = gw; row < NTOK; row += ngw) {
        const f32x4* xr = (const f32x4*)(X + (size_t)row * DM) + lane;
        f32x4 v[4]; float s = 0.f;
#pragma unroll
        for (int j = 0; j < 4; ++j) { v[j] = xr[64 * j]; s += (v[j][0] * v[j][0] + v[j][1] * v[j][1]) + (v[j][2] * v[j][2] + v[j][3] * v[j][3]); }
        const float rstd = rsqrtf(wave_sum(s) * (1.f / DM) + RMS_EPS);
        const float* mc = mods_l + (size_t)pg8::cond_of_row(row) * 6144;
        u32x2* o8 = (u32x2*)(H + (size_t)row * DM) + lane;
#pragma unroll
        for (int j = 0; j < 4; ++j) { const f32x4 sh = ((const f32x4*)(mc + ch_sh * 1024))[lane + 64 * j], sc = ((const f32x4*)(mc + ch_sc * 1024))[lane + 64 * j];
            f32x4 y;
#pragma unroll
            for (int e = 0; e < 4; ++e) y[e] = (v[j][e] * rstd * gv[j][e]) * (1.f + sc[e]) + sh[e];
            u32x2 o; o.x = pk2(y[0], y[1]); o.y = pk2(y[2], y[3]); o8[64 * j] = o; }
    }
}
__device__ __forceinline__ void final_norm_phase(const bf16_t* X, float* Y, const float* g, const float* rowsq) {
    const int tid_ = opaque_tid(); const int lane = tid_ & 63, gw = opaque_bid() * 8 + (tid_ >> 6), ngw = gridDim.x * 8;
    f32x4 gv[4];
#pragma unroll
    for (int j = 0; j < 4; ++j) gv[j] = ((const f32x4*)g)[lane + 64 * j];
    for (int row = gw; row < NTOK; row += ngw) {
        const u32x2* xr = (const u32x2*)(X + (size_t)row * DM) + lane; f32x4* yr = (f32x4*)(Y + (size_t)row * DM) + lane;
        const float rstd = rsqrtf(rowsq[row] * (1.f / DM) + RMS_EPS);
#pragma unroll
        for (int j = 0; j < 4; ++j) { const u32x2 b = xr[64 * j];
            const f32x4 x = (f32x4){__builtin_bit_cast(float, b.x << 16), __builtin_bit_cast(float, b.x & 0xffff0000u), __builtin_bit_cast(float, b.y << 16), __builtin_bit_cast(float, b.y & 0xffff0000u)};
            __builtin_nontemporal_store(x * rstd * gv[j], &yr[64 * j]); }
    }
}

template <int MIX>
__device__ __forceinline__ void qkfix_phase(bf16_t* QKV, const float* qn, const float* kn, float* kc_out) {
    const int tid_ = opaque_tid(); const int lane = tid_ & 63, gw = opaque_bid() * 8 + (tid_ >> 6), ngw = gridDim.x * 8;
    const int hl = lane & 31, head = hl >> 3, c = hl & 7, half = lane >> 5;
    float fr[8], g[8];
#pragma unroll
    for (int j = 0; j < 8; ++j) { fr[j] = __builtin_amdgcn_exp2f(-13.287712379549449f * (float)(8 * (c & 1) + j) * (1.f / 16.f)) * 0.15915494309189535f; g[j] = (MIX == 2) ? kn[8 * c + j] : 1.f; }
    const float sgn = (c & 2) ? 1.f : -1.f;
    const int row_lo = (MIX == 1) ? NCTX : 0;
    for (int rowa = row_lo + 2 * gw + half; rowa < NTOK; rowa += 4 * ngw) {
        u32x4 raw[2];
#pragma unroll
        for (int t = 0; t < 2; ++t) raw[t] = *(const u32x4*)(QKV + (size_t)(rowa + t * 2 * ngw) * 1536 + 1024 + head * 64 + 8 * c);
#pragma unroll
        for (int t = 0; t < 2; ++t) { const int row = rowa + t * 2 * ngw; const bool lat = row >= NCTX; const int tt = (row - NCTX) & 2047;
            float x[8];
            x[0] = __builtin_bit_cast(float, raw[t].x << 16); x[1] = __builtin_bit_cast(float, raw[t].x & 0xffff0000u); x[2] = __builtin_bit_cast(float, raw[t].y << 16); x[3] = __builtin_bit_cast(float, raw[t].y & 0xffff0000u);
            x[4] = __builtin_bit_cast(float, raw[t].z << 16); x[5] = __builtin_bit_cast(float, raw[t].z & 0xffff0000u); x[6] = __builtin_bit_cast(float, raw[t].w << 16); x[7] = __builtin_bit_cast(float, raw[t].w & 0xffff0000u);
            if (MIX == 2) {
                float ss = 0.f;
#pragma unroll
                for (int j = 0; j < 8; ++j) ss += x[j] * x[j];
                ss += __shfl_xor(ss, 1); ss += __shfl_xor(ss, 2); ss += __shfl_xor(ss, 4);
                const float rstd = rsqrtf(ss * (1.f / 64.f) + RMS_EPS);
#pragma unroll
                for (int j = 0; j < 8; ++j) x[j] = x[j] * rstd * g[j];
                if (!lat) { float* ko = kc_out + (size_t)row * 256 + head * 64 + 8 * c; __builtin_nontemporal_store((f32x4){x[0], x[1], x[2], x[3]}, (f32x4*)ko); __builtin_nontemporal_store((f32x4){x[4], x[5], x[6], x[7]}, (f32x4*)(ko + 4)); }
            }
            if (lat) { const float pos = (float)(c < 4 ? (tt >> 6) : (tt & 63));
#pragma unroll
                for (int j = 0; j < 8; ++j) { const float a = pos * fr[j], cs = __builtin_amdgcn_cosf(a), sn = __builtin_amdgcn_sinf(a); const float xp = __shfl_xor(x[j], 2); x[j] = x[j] * cs + sgn * xp * sn; } }
            if (lat || MIX == 2) { u32x4 o; o.x = pk2(x[0], x[1]); o.y = pk2(x[2], x[3]); o.z = pk2(x[4], x[5]); o.w = pk2(x[6], x[7]);
                *(u32x4*)(QKV + (size_t)row * 1536 + 1024 + head * 64 + 8 * c) = o; } }
    }
}

constexpr float AT_THRL = 8.f;
constexpr int AT_KP = 144, AT_VP = 192, AT_KT = 64 * AT_KP, AT_VT = 64 * AT_VP, AT_BUF = AT_KT + AT_VT, AT_RPB = 3 * AT_BUF, AT_OST = 3 * AT_BUF + 4096;
__device__ __forceinline__ s16x4 vtr(const LAS unsigned char* p) {
    typedef short v4i16_t __attribute__((ext_vector_type(4)));
    return __builtin_bit_cast(s16x4, __builtin_amdgcn_ds_read_tr16_b64_v4i16((LAS v4i16_t*)p));
}
__device__ __forceinline__ unsigned cvtpk(float lo, float hi) { unsigned r; asm volatile("v_cvt_pk_bf16_f32 %0, %1, %2" : "=v"(r) : "v"(lo), "v"(hi)); return r; }

template <int MIX>
__device__ __forceinline__ void attn_phase(LAS unsigned char* lds, const bf16_t* QKV, int ldq, int nkv, const bf16_t* CK, const bf16_t* CV, size_t cbstride,
                                           const float* rpb, const float* sink, const float* qn, bf16_t* O) {
    const int tid = opaque_tid(), wid = __builtin_amdgcn_readfirstlane(tid >> 6), lane = tid & 63, ql = lane & 31, hi = lane >> 5; const int bid = opaque_bid();
    const int G = 16 / nkv, nk = nkv * 64;
    const int lrow = tid >> 3, lch = tid & 7;
    const float C2 = 0.125f * LOG2E;
    LAS float* rpbL = (LAS float*)(lds + AT_RPB) + 64;
    const int g16 = lane >> 4, i16 = lane & 15;
    const int vtr_off = (4 * hi + (i16 >> 2)) * AT_VP + (16 * (g16 & 1) + 4 * (i16 & 3)) * 2;
    for (int u = bid; u < 1536; u += gridDim.x) {
        const bool lat = u < 1024;
        int b, h, qb;
        if (lat) { const int k_ = u >> 8, x_ = u & 7, sl_ = (u & 255) >> 3; b = 2 * k_ + (x_ >> 2); h = (x_ & 3) * 4 + (sl_ >> 3); qb = sl_ & 7; }   else { const int uu = u - 1024; b = uu >> 4; h = uu & 15; qb = 0; }
        const int kvh = h / G;
        const size_t qrow0 = lat ? (size_t)NCTX + b * 2048 + qb * 256 : (size_t)b * 256;
        const size_t lrow0 = lat ? (size_t)NCTX + b * 2048 : (size_t)b * 256;
        int lo, hiT; const int nctx = lat ? 8 : 0;
        if (!lat) { lo = 0; hiT = 3; }
        else if (MIX == 0) { lo = max(4 * qb - 4, 0); hiT = min(max(4 * qb - 1, 0), 24) + 7; }
        else if (MIX == 1) { lo = max(0, 4 * qb - 2); hiT = min(31, 4 * qb + 5); }
        else { lo = 0; hiT = 31; }
        const int nt = nctx + hiT - lo + 1;
        const bf16_t* ckb = CK + (size_t)b * cbstride + kvh * 64; const bf16_t* cvb = CV + (size_t)b * cbstride + kvh * 64;
        const bf16_t* lkb = QKV + lrow0 * ldq + 1024 + kvh * 64; const bf16_t* lvb = lkb + nk;
        bf16x8 qf[4];
        { const bf16_t* qp = QKV + (qrow0 + 32 * wid + ql) * ldq + h * 64 + 8 * hi;
#pragma unroll
          for (int s = 0; s < 4; ++s) qf[s] = *(const bf16x8*)(qp + 16 * s); }
        if (MIX != 0) {
            float qv[4][8];
#pragma unroll
            for (int s = 0; s < 4; ++s)
#pragma unroll
                for (int j = 0; j < 8; ++j) qv[s][j] = bf2f((unsigned short)qf[s][j]);
            if (MIX == 2) {
                float ss = 0.f;
#pragma unroll
                for (int s = 0; s < 4; ++s)
#pragma unroll
                    for (int j = 0; j < 8; ++j) ss += qv[s][j] * qv[s][j];
                ss += __shfl_xor(ss, 32);
                const float rstd = rsqrtf(ss * (1.f / 64.f) + RMS_EPS);
#pragma unroll
                for (int s = 0; s < 4; ++s)
#pragma unroll
                    for (int j = 0; j < 8; ++j) qv[s][j] = qv[s][j] * rstd * qn[16 * s + 8 * hi + j];
            }
            if (lat) {
                const int t = (int)(qrow0 + 32 * wid + ql - NCTX) & 2047; const float rp = (float)(t >> 6), cp = (float)(t & 63);
#pragma unroll
                for (int j = 0; j < 8; ++j) {
                    const float fr = __builtin_amdgcn_exp2f(-13.287712379549449f * (float)(8 * hi + j) * (1.f / 16.f)) * 0.15915494309189535f;
                    const float c1 = __builtin_amdgcn_cosf(rp * fr), s1 = __builtin_amdgcn_sinf(rp * fr), c2 = __builtin_amdgcn_cosf(cp * fr), s2 = __builtin_amdgcn_sinf(cp * fr);
                    const float a1 = qv[0][j], a2 = qv[1][j], b1 = qv[2][j], b2 = qv[3][j];
                    qv[0][j] = a1 * c1 - a2 * s1; qv[1][j] = a2 * c1 + a1 * s1; qv[2][j] = b1 * c2 - b2 * s2; qv[3][j] = b2 * c2 + b1 * s2;
                }
            }
#pragma unroll
            for (int s = 0; s < 4; ++s) { u32x4 w; w.x = cvtpk(qv[s][0] * C2, qv[s][1] * C2); w.y = cvtpk(qv[s][2] * C2, qv[s][3] * C2); w.z = cvtpk(qv[s][4] * C2, qv[s][5] * C2); w.w = cvtpk(qv[s][6] * C2, qv[s][7] * C2); qf[s] = __builtin_bit_cast(bf16x8, w); }
        } else {
#pragma unroll
            for (int s = 0; s < 4; ++s) { u32x4 w; w.x = cvtpk(bf2f((unsigned short)qf[s][0]) * C2, bf2f((unsigned short)qf[s][1]) * C2); w.y = cvtpk(bf2f((unsigned short)qf[s][2]) * C2, bf2f((unsigned short)qf[s][3]) * C2);
                w.z = cvtpk(bf2f((unsigned short)qf[s][4]) * C2, bf2f((unsigned short)qf[s][5]) * C2); w.w = cvtpk(bf2f((unsigned short)qf[s][6]) * C2, bf2f((unsigned short)qf[s][7]) * C2); qf[s] = __builtin_bit_cast(bf16x8, w); }
        }
        float mhat = 0.f, l = 0.f;
        f32x16 O0, O1;
#pragma unroll
        for (int r = 0; r < 16; ++r) { O0[r] = 0.f; O1[r] = 0.f; }
        const int rq = 4 * qb + (wid >> 1), r0 = min(max(rq - 4, 0), 24);
        const int cq = 32 * (wid & 1) + ql, c0 = min(max(cq - 8, 0), 48);
        const int qw0 = 256 * qb + 32 * wid, tq = qw0 + ql;
        u32x4 kA, vA;
#define AT_LOAD(i, KR, VR) do { const int _i = (i); int _t_ = tid; asm volatile("" : "+v"(_t_)); const int _lr = _t_ >> 3, _lc = _t_ & 7; \
        if (_i < nctx) { const size_t _t = (size_t)_i * 64 * nk * 2; const unsigned _o = (unsigned)(_lr * nk + _lc * 8) * 2u; KR = *(const u32x4*)((const char*)ckb + _t + _o); VR = *(const u32x4*)((const char*)cvb + _t + _o); } \
        else { const size_t _t = (size_t)(lo + _i - nctx) * 64 * ldq * 2; const unsigned _o = (unsigned)(_lr * ldq + _lc * 8) * 2u; KR = *(const u32x4*)((const char*)lkb + _t + _o); VR = *(const u32x4*)((const char*)lvb + _t + _o); } } while (0)
#define AT_STORE(bufi, KR, VR) do { int _t_ = tid; asm volatile("" : "+v"(_t_)); const int _lr = _t_ >> 3, _lc = _t_ & 7; LAS unsigned char* _b = lds + (bufi) * AT_BUF; \
        *(LAS u32x4*)(_b + _lr * AT_KP + _lc * 16) = KR; *(LAS u32x4*)(_b + AT_KT + _lr * AT_VP + _lc * 16) = VR; } while (0)
#define AT_KLOAD(slot, h_) do { const LAS unsigned char* _kb = lds + (slot) * AT_BUF + ql * AT_KP + hi * 16 + (h_) * 64; \
        _Pragma("unroll") for (int _s = 0; _s < 2; ++_s) { ka[_s] = *(const LAS bf16x8*)(_kb + _s * 32); kc[_s] = *(const LAS bf16x8*)(_kb + 32 * AT_KP + _s * 32); } } while (0)
#define AT_QK0(N0, N1) do { N0 = __builtin_amdgcn_mfma_f32_32x32x16_bf16(ka[0], qf[0], negm, 0, 0, 0); N1 = __builtin_amdgcn_mfma_f32_32x32x16_bf16(kc[0], qf[0], negm, 0, 0, 0); } while (0)
#define AT_QKSTEP(_s, N0, N1) do { N0 = __builtin_amdgcn_mfma_f32_32x32x16_bf16(ka[(_s) & 1], qf[_s], N0, 0, 0, 0); N1 = __builtin_amdgcn_mfma_f32_32x32x16_bf16(kc[(_s) & 1], qf[_s], N1, 0, 0, 0); } while (0)
#define AT_VLOAD(slot, _sb) do { const LAS unsigned char* _vb = lds + (slot) * AT_BUF + AT_KT + vtr_off; \
        _Pragma("unroll") for (int _s = 0; _s < 2; ++_s) { const LAS unsigned char* _vp = _vb + (32 * (_sb) + 16 * _s) * AT_VP; \
            const s16x4 _a0l = vtr(_vp), _a0h = vtr(_vp + 8 * AT_VP), _a1l = vtr(_vp + 64), _a1h = vtr(_vp + 64 + 8 * AT_VP); \
            vf0[_s] = (bf16x8){_a0l[0], _a0l[1], _a0l[2], _a0l[3], _a0h[0], _a0h[1], _a0h[2], _a0h[3]}; \
            vf1[_s] = (bf16x8){_a1l[0], _a1l[1], _a1l[2], _a1l[3], _a1h[0], _a1h[1], _a1h[2], _a1h[3]}; } } while (0)
#define AT_MASKMAX(ti, P0, P1) do { const int _ti = (ti); const int _lt = lo + _ti - nctx; \
        if (MIX == 0 && lat && _ti >= nctx) { const LAS float* rb_ = rpbL + ((_lt - rq + 7) * 31 + 15 - cq + 4 * hi); const bool rowok = (_lt >= r0 && _lt < r0 + 8); const int cb_ = 4 * hi - c0; \
            _Pragma("unroll") for (int r = 0; r < 16; ++r) { const int kq_ = (r & 3) + 8 * (r >> 2); const bool ok = rowok && (unsigned)(kq_ + cb_) < 16u; P0[r] = ok ? P0[r] + rb_[kq_] : -1e30f; } \
            AT_SB(); \
            _Pragma("unroll") for (int r = 0; r < 16; ++r) { const int kq_ = (r & 3) + 8 * (r >> 2) + 32; const bool ok = rowok && (unsigned)(kq_ + cb_) < 16u; P1[r] = ok ? P1[r] + rb_[kq_] : -1e30f; } } \
        else if (MIX == 1 && lat && _ti >= nctx) { const int d_ = 64 * _lt + 4 * hi - tq + 128; \
            _Pragma("unroll") for (int r = 0; r < 16; ++r) { const int kq_ = (r & 3) + 8 * (r >> 2); \
                P0[r] = ((unsigned)(kq_ + d_) <= 256u) ? P0[r] : -1e30f; P1[r] = ((unsigned)(kq_ + 32 + d_) <= 256u) ? P1[r] : -1e30f; } } \
        float mx = fmaxf(P0[0], P1[0]); \
        _Pragma("unroll") for (int r = 1; r < 16; ++r) mx = fmaxf(fmaxf(mx, P0[r]), P1[r]); \
        { const auto _rr = __builtin_amdgcn_permlane32_swap(__float_as_uint(mx), __float_as_uint(mx), false, false); mx = fmaxf(__uint_as_float(_rr[0]), __uint_as_float(_rr[1])); } \
        const bool first_ = (_ti == 0); \
        if (first_ || __builtin_amdgcn_ballot_w64(mx > AT_THRL) != 0ull) { const float dl = first_ ? mx : fmaxf(mx, 0.f); mhat += dl; \
            _Pragma("unroll") for (int r = 0; r < 16; ++r) { P0[r] -= dl; P1[r] -= dl; } \
            const float f = first_ ? 1.f : __builtin_amdgcn_exp2f(-dl); l *= f;     \
            _Pragma("unroll") for (int r = 0; r < 16; ++r) { O0[r] *= f; O1[r] *= f; } \
            _Pragma("unroll") for (int r = 0; r < 16; ++r) negm[r] = -mhat; } } while (0)
#define AT_EXP(P) do { _Pragma("unroll") for (int r = 0; r < 16; ++r) P[r] = __builtin_amdgcn_exp2f(P[r]); } while (0)
#define AT_FIN(P0, P1) do { float ls0 = 0.f, ls1 = 0.f; _Pragma("unroll") for (int r = 0; r < 16; ++r) { ls0 += P0[r]; ls1 += P1[r]; } \
        l += (ls0 + ls1); \
        _Pragma("unroll") for (int _s = 0; _s < 2; ++_s) { u32x4 w0, w1; \
            w0.x = cvtpk(P0[8 * _s + 0], P0[8 * _s + 1]); w0.y = cvtpk(P0[8 * _s + 2], P0[8 * _s + 3]); w0.z = cvtpk(P0[8 * _s + 4], P0[8 * _s + 5]); w0.w = cvtpk(P0[8 * _s + 6], P0[8 * _s + 7]); \
            w1.x = cvtpk(P1[8 * _s + 0], P1[8 * _s + 1]); w1.y = cvtpk(P1[8 * _s + 2], P1[8 * _s + 3]); w1.z = cvtpk(P1[8 * _s + 4], P1[8 * _s + 5]); w1.w = cvtpk(P1[8 * _s + 6], P1[8 * _s + 7]); \
            pf[0][_s] = __builtin_bit_cast(bf16x8, w0); pf[1][_s] = __builtin_bit_cast(bf16x8, w1); } } while (0)
#define AT_PV(_sb) do { _Pragma("unroll") for (int _s = 0; _s < 2; ++_s) { \
            O0 = __builtin_amdgcn_mfma_f32_32x32x16_bf16(vf0[_s], pf[_sb][_s], O0, 0, 0, 0); O1 = __builtin_amdgcn_mfma_f32_32x32x16_bf16(vf1[_s], pf[_sb][_s], O1, 0, 0, 0); } } while (0)
#define AT_SB() __builtin_amdgcn_sched_barrier(0)
#define AT_STEP(i_, P0, P1, N0, N1) do { const int _si = (i_); \
        const int slot1 = slot == 2 ? 0 : slot + 1, slot2 = slot1 == 2 ? 0 : slot1 + 1; \
        AT_KLOAD(slot1, 0); \
        AT_MASKMAX(_si, P0, P1); \
        AT_SB(); AT_QK0(N0, N1); AT_SB(); \
        AT_EXP(P0); \
        AT_SB(); AT_QKSTEP(1, N0, N1); AT_SB(); AT_KLOAD(slot1, 1); AT_SB(); \
        if (_si + 2 < nt) AT_STORE(slot2, kA, vA);     \
        if (_si + 3 < nt) AT_LOAD(_si + 3, kA, vA); \
        AT_SB(); \
        AT_EXP(P1); \
        AT_SB(); AT_QKSTEP(2, N0, N1); AT_SB(); \
        AT_VLOAD(slot, 0); \
        AT_FIN(P0, P1); \
        AT_SB(); AT_QKSTEP(3, N0, N1); AT_SB(); \
        AT_PV(0); AT_SB(); AT_VLOAD(slot, 1); AT_PV(1); \
        __syncthreads(); \
        slot = slot1; } while (0)
#define AT_TAIL(P0, P1) do { AT_VLOAD(slot, 0); AT_MASKMAX(nt - 1, P0, P1); AT_EXP(P0); AT_EXP(P1); AT_FIN(P0, P1); AT_PV(0); AT_SB(); AT_VLOAD(slot, 1); AT_PV(1); } while (0)
        f32x16 p0, p1, n0, n1, negm; bf16x8 ka[2], kc[2], vf0[2], vf1[2], pf[2][2];
#pragma unroll
        for (int r = 0; r < 16; ++r) negm[r] = 0.f;
        { u32x4 kB, vB;
          AT_LOAD(0, kA, vA); AT_LOAD(1, kB, vB);
          __syncthreads();
          if (MIX == 0 && lat) { for (int i = tid; i < 465; i += 512) rpbL[i] = rpb[h * 465 + i] * LOG2E; }
          AT_STORE(0, kA, vA); AT_STORE(1, kB, vB); }
        AT_LOAD(2, kA, vA);
        __syncthreads();
        { AT_KLOAD(0, 0); AT_QK0(p0, p1); AT_QKSTEP(1, p0, p1); AT_SB(); AT_KLOAD(0, 1); AT_QKSTEP(2, p0, p1); AT_QKSTEP(3, p0, p1); }
        int slot = 0;
        int i = 0;
        for (; i + 2 < nt; i += 2) {
            AT_STEP(i, p0, p1, n0, n1);
            AT_STEP(i + 1, n0, n1, p0, p1);
        }
        if (i + 1 < nt) { AT_STEP(i, p0, p1, n0, n1); p0 = n0; p1 = n1; }
        AT_TAIL(p0, p1);
#undef AT_LOAD
#undef AT_STORE
        if (MIX == 1 && hi == 0) l += __builtin_amdgcn_exp2f(sink[h] * LOG2E - mhat);
        const float lt_ = l + __shfl_xor(l, 32), inv = 1.f / lt_;
        { LAS unsigned char* stg = lds + AT_OST + wid * (32 * 144);
#pragma unroll
          for (int rg = 0; rg < 4; ++rg) {
              u32x2 w0, w1;
              w0.x = cvtpk(O0[4 * rg + 0] * inv, O0[4 * rg + 1] * inv); w0.y = cvtpk(O0[4 * rg + 2] * inv, O0[4 * rg + 3] * inv);
              w1.x = cvtpk(O1[4 * rg + 0] * inv, O1[4 * rg + 1] * inv); w1.y = cvtpk(O1[4 * rg + 2] * inv, O1[4 * rg + 3] * inv);
              *(LAS u32x2*)(stg + ql * 144 + (8 * rg + 4 * hi) * 2) = w0; *(LAS u32x2*)(stg + ql * 144 + (32 + 8 * rg + 4 * hi) * 2) = w1;
          }
          asm volatile("s_waitcnt lgkmcnt(0)" ::: "memory");
          bf16_t* ob = O + (qrow0 + 32 * wid) * 1024 + h * 64;
#pragma unroll
          for (int i4 = 0; i4 < 4; ++i4) { const int row = i4 * 8 + (lane >> 3), ch = lane & 7; const u32x4 v = *(const LAS u32x4*)(stg + row * 144 + ch * 16); __builtin_nontemporal_store(v, (u32x4*)(ob + (size_t)row * 1024 + ch * 8)); }
          asm volatile("s_waitcnt lgkmcnt(0)" ::: "memory");
        }
    }
}

__global__ void __launch_bounds__(512, 2) hybrid_fwd(Params Pbyval) {
    extern __shared__ __attribute__((aligned(16))) unsigned char lds_raw[];
    LAS unsigned char* lds = (LAS unsigned char*)lds_raw;
    cg::grid_group grid = cg::this_grid();
    const KP Pk = (KP)__builtin_amdgcn_kernarg_segment_ptr();
#define PARAMS() ({ KP _p = Pk; asm volatile("" : "+s"(_p)); _p; })
    { volatile LAS unsigned* st0 = (volatile LAS unsigned*)(lds + 131072 + 1024); if (threadIdx.x < 2) st0[threadIdx.x] = 0u; }
    __syncthreads();
    XcdBarrier bar = xcd_barrier_post((unsigned*)(Pk->ws + WS_BAR), (volatile LAS unsigned*)(lds + 131072 + 1024));
    if (Pk->ph_lo < 0) grid.sync();
    int ph = 0;
#define PH_BEGIN { KP q = PARAMS(); if (ph >= q->ph_lo && ph < q->ph_hi) { unsigned char* const ws = q->ws; bf16_t* const X = (bf16_t*)(ws + WS_X); (void)ws; (void)X;
#define PH_END } } { KP q2 = PARAMS(); const bool _in = ph >= q2->ph_lo && ph + 1 < q2->ph_hi; ++ph; if (_in) { for (int rs = 0; rs < REP_SYNC; ++rs) xcd_barrier(bar); } }
#define PH_END_IF(cnd) } } { KP q2 = PARAMS(); const bool _in = ph >= q2->ph_lo && ph + 1 < q2->ph_hi; ++ph; if (_in && (cnd)) { for (int rs = 0; rs < REP_SYNC; ++rs) xcd_barrier(bar); } }

    PH_BEGIN
        const int tid = opaque_tid(), lane = tid & 63, wave = tid >> 6; const int bid = opaque_bid();
        const int gw = bid * 8 + wave, ngw = gridDim.x * 8;
        for (int rep = 0; rep < REP_P0; ++rep) {
        mods_phase(q, lds);
        LAS float* scr = (LAS float*)(lds + wave * 16384);
#pragma unroll 1
        for (int l = 0; l < 4; ++l) {
            transpose_matrix(q->in[14] + (size_t)l * DM * DM, DM, DM, (bf16_t*)(ws + WS_WO + l * 2 * MiB), scr, gw, ngw, lane);
            transpose_matrix(q->in[15] + (size_t)l * DM * DFF, DM, DFF, (bf16_t*)(ws + WS_W1 + l * 8 * MiB), scr, gw, ngw, lane);
            transpose_matrix(q->in[17] + (size_t)l * DFF * DM, DFF, DM, (bf16_t*)(ws + WS_W2 + l * 8 * MiB), scr, gw, ngw, lane);
        }
#pragma unroll 1
        for (int j = 0; j < 2; ++j) transpose_matrix(q->in[19] + (size_t)j * DM * 3072, DM, 3072, (bf16_t*)(ws + WS_QKVA + j * 6 * MiB), scr, gw, ngw, lane);
        transpose_matrix(q->in[21], DM, 1536, (bf16_t*)(ws + WS_QKVB), scr, gw, ngw, lane);
        transpose_matrix(q->in[23], DM, 1536, (bf16_t*)(ws + WS_QKVC), scr, gw, ngw, lane);
        const size_t gt = (size_t)bid * 512 + tid, ngt = (size_t)gridDim.x * 512;
        convert_array(q->in[2], (bf16_t*)(ws + WS_CKA), 8388608 / 4, gt, ngt);
        convert_array(q->in[3], (bf16_t*)(ws + WS_CVA), 8388608 / 4, gt, ngt);
        convert_array(q->in[4], (bf16_t*)(ws + WS_CKB), 1048576 / 4, gt, ngt);
        convert_array(q->in[5], (bf16_t*)(ws + WS_CVB), 1048576 / 4, gt, ngt);
        convert_array(q->in[6], (bf16_t*)(ws + WS_CKC), 1048576 / 4, gt, ngt);
        convert_array(q->in[7], (bf16_t*)(ws + WS_CVC), 1048576 / 4, gt, ngt);
        { f32x4* rz = (f32x4*)(ws + WS_ROWSQ); for (size_t i = gt; i < (size_t)9 * NTOK / 4; i += ngt) rz[i] = (f32x4){0.f, 0.f, 0.f, 0.f}; }
        }
    PH_END
    PH_BEGIN
        shw_phase(q, lds);
        xin_phase(q->in[0], q->in[1], X, (bf16_t*)(ws + WS_H), (float*)(ws + WS_ROWSQ), q->in[12], (const float*)(ws + WS_MODS));
    PH_END

#pragma unroll 1
    for (int l = 0; l < 4; ++l) {
        PH_BEGIN
            const int mix = l % 3, j = l / 3; const int nkv = mix == 0 ? 16 : 4, nk = nkv * 64, nqkv = 1024 + 2 * nk;
            const bf16_t* Wt = (const bf16_t*)(ws + (mix == 0 ? WS_QKVA + (size_t)j * 6 * MiB : (mix == 1 ? WS_QKVB : WS_QKVC)));
            float* ko = q->out + (mix == 0 ? OUT_KA : (mix == 1 ? OUT_KB : OUT_KC)); float* vo = q->out + (mix == 0 ? OUT_VA : (mix == 1 ? OUT_VB : OUT_VC));
            const int c = opaque_bid(); const int nwg = (NTOK / 256) * (nqkv / 256), full = (nwg / 256) * 256;
            pg8::Gemm g{(const bf16_t*)(ws + WS_H), Wt, NTOK, nqkv, DM}; pg8::StaticOrder S; S.init(NTOK, nqkv, gridDim.x, c);
            pg8::EpiQKV E{(bf16_t*)(ws + WS_QKV), nqkv, nk, ko, vo, mix == 0 ? 2 : 1, mix == 0 ? j : 0, (const float*)(ws + WS_ROWSQ) + (size_t)(2 * l) * NTOK, (const float*)(ws + WS_SHW) + (size_t)(2 * l) * 9 * 4096, 0, 0};
            if (gridDim.x == 256) {
                S.lim = full;
                pg8::gemm_phase<pg8::EpiQKV, pg8::StaticOrder, true, true>(lds, g, S, E);
                const int pr = (c & 7) + 8 * (c >> 4), hf = (c >> 3) & 1;
                if (full + pr < nwg) {
                    pg8::OneUnit S1; S.map(full + pr, S1.u); pg8::Gemm g2{(const bf16_t*)(ws + WS_H) + (size_t)hf * 128 * DM, Wt, NTOK, nqkv, DM};
                    pg8::EpiQKV E2 = E; E2.halfm = 1; E2.rowoff = hf * 128;
                    pg8::gemm_phase<pg8::EpiQKV, pg8::OneUnit, true, true, true>(lds, g2, S1, E2);
                }
            } else pg8::gemm_phase<pg8::EpiQKV, pg8::StaticOrder, true, true>(lds, g, S, E);
        PH_END
        PH_BEGIN
            const int mix = l % 3;
            if (mix == 1) qkfix_phase<1>((bf16_t*)(ws + WS_QKV), nullptr, nullptr, nullptr);
            else if (mix == 2) qkfix_phase<2>((bf16_t*)(ws + WS_QKV), q->in[24], q->in[25], q->out + OUT_KC);
        PH_END_IF((l % 3) != 0)
        PH_BEGIN
            const int mix = l % 3, j = l / 3;
            const bf16_t* QKV = (const bf16_t*)(ws + WS_QKV); bf16_t* AO = (bf16_t*)(ws + WS_O);
            for (int rep = 0; rep < REP_ATTN; ++rep)
            if (mix == 0) attn_phase<0>(lds, QKV, 3072, 16, (const bf16_t*)(ws + WS_CKA) + (size_t)j * 512 * 1024, (const bf16_t*)(ws + WS_CVA) + (size_t)j * 512 * 1024, (size_t)2 * 512 * 1024, q->in[20] + (size_t)j * 16 * 465, nullptr, nullptr, AO);
            else if (mix == 1) attn_phase<1>(lds, QKV, 1536, 4, (const bf16_t*)(ws + WS_CKB), (const bf16_t*)(ws + WS_CVB), (size_t)512 * 256, nullptr, q->in[22], nullptr, AO);
            else attn_phase<2>(lds, QKV, 1536, 4, (const bf16_t*)(ws + WS_CKC), (const bf16_t*)(ws + WS_CVC), (size_t)512 * 256, nullptr, nullptr, q->in[24], AO);
        PH_END
        PH_BEGIN
            const bf16_t* A_ = (const bf16_t*)(ws + WS_O); const bf16_t* B_ = (const bf16_t*)(ws + WS_WO + (size_t)l * 2 * MiB);
            pg8::EpiResGate E{X, (const float*)(ws + WS_MODS) + (size_t)l * 9 * 6144 + 2 * 1024, nullptr, (float*)(ws + WS_ROWSQ) + (size_t)(2 * l + 1) * NTOK, (bf16_t*)(ws + WS_H), q->in[13] + l * DM, (const float*)(ws + WS_MODS) + (size_t)l * 9 * 6144 + 4 * 1024, 0, 0};
            const int c = opaque_bid();
            if (gridDim.x == 256) {
                pg8::StaticOrder so; so.init(NTOK, DM, 256, c);
                { pg8::OneUnit S; so.map(c, S.u); pg8::Gemm g{A_, B_, NTOK, DM, DM};
                  pg8::gemm_phase<pg8::EpiResGate, pg8::OneUnit, true, true>(lds, g, S, E); }
                { const int pr = (c & 7) + 8 * (c >> 4), hf = (c >> 3) & 1;
                  pg8::OneUnit S; so.map(256 + pr, S.u); pg8::Gemm g{A_ + (size_t)hf * 128 * DM, B_, NTOK, DM, DM};
                  pg8::EpiResGate E2 = E; E2.halfm = 1; E2.rowoff = hf * 128;
                  pg8::gemm_phase<pg8::EpiResGate, pg8::OneUnit, true, true, true>(lds, g, S, E2); }
            } else {
                pg8::Gemm g{A_, B_, NTOK, DM, DM}; pg8::StaticOrder S; S.init(NTOK, DM, gridDim.x, c);
                pg8::gemm_phase<pg8::EpiResGate, pg8::StaticOrder, true, true>(lds, g, S, E);
            }
        PH_END
        PH_BEGIN
            pg8::Gemm g{(const bf16_t*)(ws + WS_H), (const bf16_t*)(ws + WS_W1 + (size_t)l * 8 * MiB), NTOK, DFF, DM}; pg8::StaticOrder S; S.init(NTOK, DFF, gridDim.x, opaque_bid());
            pg8::EpiSqRelu E{(bf16_t*)(ws + WS_U), DFF, (const float*)(ws + WS_ROWSQ) + (size_t)(2 * l + 1) * NTOK, (const float*)(ws + WS_SHW) + (size_t)(2 * l + 1) * 9 * 4096};
            for (int rep = 0; rep < REP_GEMM; ++rep) pg8::gemm_phase<pg8::EpiSqRelu, pg8::StaticOrder, true, true>(lds, g, S, E);
        PH_END
        PH_BEGIN
            const bf16_t* A_ = (const bf16_t*)(ws + WS_U); const bf16_t* B_ = (const bf16_t*)(ws + WS_W2 + (size_t)l * 8 * MiB);
            pg8::EpiResGate E{X, (const float*)(ws + WS_MODS) + (size_t)l * 9 * 6144 + 5 * 1024, q->in[18] + l * DM, (float*)(ws + WS_ROWSQ) + (size_t)(2 * l + 2) * NTOK, l < 3 ? (bf16_t*)(ws + WS_H) : nullptr, q->in[12] + (l < 3 ? l + 1 : 0) * DM, (const float*)(ws + WS_MODS) + (size_t)(l < 3 ? l + 1 : 0) * 9 * 6144 + 1 * 1024, 0, 0};
            const int c = opaque_bid();
            if (gridDim.x == 256) {
                pg8::StaticOrder so; so.init(NTOK, DM, 256, c);
                { pg8::OneUnit S; so.map(c, S.u); pg8::Gemm g{A_, B_, NTOK, DM, DFF};
                  pg8::gemm_phase<pg8::EpiResGate, pg8::OneUnit, true, true>(lds, g, S, E); }
                { const int pr = (c & 7) + 8 * (c >> 4), hf = (c >> 3) & 1;
                  pg8::OneUnit S; so.map(256 + pr, S.u); pg8::Gemm g{A_ + (size_t)hf * 128 * DFF, B_, NTOK, DM, DFF};
                  pg8::EpiResGate E2 = E; E2.halfm = 1; E2.rowoff = hf * 128;
                  pg8::gemm_phase<pg8::EpiResGate, pg8::OneUnit, true, true, true>(lds, g, S, E2); }
            } else {
                pg8::Gemm g{A_, B_, NTOK, DM, DFF}; pg8::StaticOrder S; S.init(NTOK, DM, gridDim.x, c);
                pg8::gemm_phase<pg8::EpiResGate, pg8::StaticOrder, true, true>(lds, g, S, E);
            }
        PH_END
    }
    PH_BEGIN
        final_norm_phase(X, q->out + OUT_X, q->in[26], (const float*)(ws + WS_ROWSQ) + (size_t)8 * NTOK);
    PH_END
}
constexpr int N_PHASES = 2 + 4 * 6 + 1;

extern "C" void kernel_launch(void* const* d_in, const int* in_sizes, int n_in, void* d_out, int out_size, void* d_ws, size_t ws_size, hipStream_t stream) {
    static int grid = 0;
    if (grid == 0) {
        if (n_in != 27 || out_size != 67108864 || ws_size < WS_END) { fprintf(stderr, "kernel_launch: unexpected shapes n_in %d out %d ws %zu\n", n_in, out_size, ws_size); grid = -1; return; }
        int dev = 0, cus = 0, per_cu = 0;
        (void)hipGetDevice(&dev); (void)hipDeviceGetAttribute(&cus, hipDeviceAttributeMultiprocessorCount, dev);
        (void)hipFuncSetAttribute((const void*)hybrid_fwd, hipFuncAttributeMaxDynamicSharedMemorySize, LDS_BYTES);
        (void)hipOccupancyMaxActiveBlocksPerMultiprocessor(&per_cu, (const void*)hybrid_fwd, 512, LDS_BYTES);
        if (per_cu < 1) { fprintf(stderr, "kernel_launch: occupancy query says %d blocks per CU\n", per_cu); per_cu = 1; }
        (void)hipGetLastError();
        grid = cus;
    }
    if (grid < 0) return;
    (void)hipMemsetAsync((unsigned char*)d_ws + WS_BAR, 0, XCD_BAR_WORDS * 4, stream);
    Params p{};
    for (int i = 0; i < 27; ++i) p.in[i] = (const float*)d_in[i];
    p.out = (float*)d_out; p.ws = (unsigned char*)d_ws;
#ifdef MK_MULTI
    for (int ph = 0; ph < N_PHASES; ++ph) { p.ph_lo = ph; p.ph_hi = ph + 1; hipLaunchKernelGGL(hybrid_fwd, dim3(grid), dim3(512), LDS_BYTES, stream, p); }
#else
    p.ph_lo = 0; p.ph_hi = N_PHASES;
    void* args[] = {&p};
    hipError_t e = hipLaunchCooperativeKernel((const void*)hybrid_fwd, dim3(grid), dim3(512), args, LDS_BYTES, stream);
    if (e != hipSuccess) fprintf(stderr, "cooperative launch failed: %s (grid %d)\n", hipGetErrorString(e), grid);
#endif
}
```

```cpp
#include <hip/hip_runtime.h>
#include <hip/hip_cooperative_groups.h>
#include <cstdio>
#include <cstdint>
namespace cg = cooperative_groups;

__device__ __forceinline__ int opaque_tid() { int t = threadIdx.x; asm volatile("" : "+v"(t)); return t; }
__device__ __forceinline__ int opaque_bid() { int b = blockIdx.x; asm volatile("" : "+s"(b)); return b; }
namespace pg8 {
#define PG8_LAS __attribute__((address_space(3)))
typedef unsigned short bf16_t;
typedef short bf16x8 __attribute__((ext_vector_type(8)));
typedef float f32x4 __attribute__((ext_vector_type(4)));
typedef unsigned u32x4 __attribute__((ext_vector_type(4)));
constexpr int BM = 256, BK = 64, HALF = 128, HTB = HALF * BK * 2  , STAGE_BYTES = 8 * HTB, NXCD = 8, WGM = 8;

__host__ __device__ __forceinline__ int lds_byte(int r, int c) { const int st = (r >> 4) * 2 + (c >> 5), rr = r & 15, cc = c & 31, ob = rr * 64 + cc * 2; return st * 1024 + (ob ^ (((ob >> 9) & 1) << 5)); }
__host__ __device__ __forceinline__ void stage_rc(int b, int& R, int& C) { const int st = b / 1024, sb = b % 1024, swz = sb ^ (((sb >> 9) & 1) << 5); R = (st >> 1) * 16 + swz / 64; C = (st & 1) * 32 + (swz % 64) / 2; }
__host__ __device__ __forceinline__ int perm32(int rho) { const int n = rho >> 4, i = rho & 15; return 8 * (i >> 2) + 4 * n + (i & 3); }

struct Unit { int pm, pn; };
struct Gemm { const bf16_t* A; const bf16_t* Bt; int M, N, K; };

struct StaticOrder {
    int nM, nN, nwg, G, c, lim;
    __host__ __device__ void init(int M, int N, int G_, int c_) { nM = M / BM; nN = N / BM; nwg = nM * nN; G = G_; c = c_; lim = nwg; }
    __host__ __device__ __forceinline__ void map(int L, Unit& u) const {
        int wgid = L; { const int q = nwg / NXCD, r = nwg % NXCD, xcd = wgid % NXCD, off = wgid / NXCD; wgid = (xcd < r ? xcd * (q + 1) : r * (q + 1) + (xcd - r) * q) + off; }
        const int nig = WGM * nN, gid = wgid / nig, fm = gid * WGM, gsz = (nM - fm) < WGM ? (nM - fm) : WGM;
        u.pm = fm + ((wgid % nig) % gsz); u.pn = (wgid % nig) / gsz;
    }
    __host__ __device__ bool next(int i, Unit& u) const {
        const long L = (long)i * G + c; if (L >= lim) return false;
        map((int)L, u); return true;
    }
    __device__ __forceinline__ void a_ready(const Unit&) const {}
    __device__ __forceinline__ void done(const Unit&) const {}
};
struct OneUnit {
    Unit u;
    __host__ __device__ bool next(int i, Unit& v) const { if (i != 0) return false; v = u; return true; }
    __device__ __forceinline__ void a_ready(const Unit&) const {}
    __device__ __forceinline__ void done(const Unit&) const {}
};

__device__ __forceinline__ unsigned cvt_pk_bf16(float lo, float hi) { unsigned r; asm volatile("v_cvt_pk_bf16_f32 %0, %1, %2" : "=v"(r) : "v"(lo), "v"(hi)); return r; }
typedef float f32x2 __attribute__((ext_vector_type(2)));
typedef unsigned u32x2 __attribute__((ext_vector_type(2)));
__device__ __forceinline__ int cond_of_row(int row) { return row < 8192 ? 8 : ((row - 8192) >> 11); }

struct EpiQKV {
    static constexpr bool PERM = true, AFTER_DRAIN = false;
    bf16_t* O; int ldc; int nk;
    float* kout; float* vout; int nj, j;
    const float* rowsq; const float* shw;
    int halfm, rowoff;
    __device__ __forceinline__ void operator()(const f32x4 (&acc)[2][2][4][2], const Unit& u, int wr, int wc, int fr, int fq) const {
        const int row0 = u.pm * BM + rowoff + wr * 64 + fr; const int colt = u.pn * BM;
        const int col0 = colt + wc * 32 + 8 * fq;
        float* fout = nullptr; int fc0 = 0;
        if (u.pm < 32 && colt >= 1024) { if (colt - 1024 < nk) { fout = kout; fc0 = col0 - 1024; } else { fout = vout; fc0 = col0 - 1024 - nk; } }
        const float* sw = shw + (size_t)cond_of_row(u.pm * BM) * ldc + col0;
        f32x4 bv[2][2];
#pragma unroll
        for (int bj = 0; bj < 2; ++bj)
#pragma unroll
            for (int n = 0; n < 2; ++n) bv[bj][n] = *(const f32x4*)(sw + bj * HALF + 4 * n);
#pragma unroll
        for (int ai = 0; ai < 2; ++ai) { if (halfm && ai == 1) break;
#pragma unroll
            for (int m = 0; m < 4; ++m) { const int row = row0 + ai * HALF + m * 16; bf16_t* rowp = O + (size_t)row * ldc + col0;
                const float rstd = rsqrtf(rowsq[row] * (1.f / 1024.f) + 1e-6f);
                float* frow = fout ? fout + ((size_t)((row >> 8) * nj + j) * 256 + (row & 255)) * nk + fc0 : nullptr;
#pragma unroll
                for (int bj = 0; bj < 2; ++bj) { const f32x4 v0 = acc[ai][bj][m][0] * rstd + bv[bj][0], v1 = acc[ai][bj][m][1] * rstd + bv[bj][1];
                    u32x4 w; w.x = cvt_pk_bf16(v0[0], v0[1]); w.y = cvt_pk_bf16(v0[2], v0[3]); w.z = cvt_pk_bf16(v1[0], v1[1]); w.w = cvt_pk_bf16(v1[2], v1[3]);
                    *(u32x4*)(rowp + bj * HALF) = w;
                    if (fout) { __builtin_nontemporal_store(v0, (f32x4*)(frow + bj * HALF)); __builtin_nontemporal_store(v1, (f32x4*)(frow + bj * HALF + 4)); } } } }
    }
};
struct EpiSqRelu {
    static constexpr bool PERM = true, AFTER_DRAIN = false;
    bf16_t* O; int ldc; const float* rowsq; const float* shw;
    __device__ __forceinline__ void operator()(const f32x4 (&acc)[2][2][4][2], const Unit& u, int wr, int wc, int fr, int fq) const {
        const int row0 = u.pm * BM + wr * 64 + fr; const int col0 = u.pn * BM + wc * 32 + 8 * fq;
        const float* sw = shw + (size_t)cond_of_row(u.pm * BM) * ldc + col0;
        f32x4 bv[2][2];
#pragma unroll
        for (int bj = 0; bj < 2; ++bj)
#pragma unroll
            for (int n = 0; n < 2; ++n) bv[bj][n] = *(const f32x4*)(sw + bj * HALF + 4 * n);
#pragma unroll
        for (int ai = 0; ai < 2; ++ai)
#pragma unroll
            for (int m = 0; m < 4; ++m) { const int row = row0 + ai * HALF + m * 16; bf16_t* rowp = O + (size_t)row * ldc + col0;
                const float rstd = rsqrtf(rowsq[row] * (1.f / 1024.f) + 1e-6f);
#pragma unroll
                for (int bj = 0; bj < 2; ++bj) { f32x4 v0 = acc[ai][bj][m][0] * rstd + bv[bj][0], v1 = acc[ai][bj][m][1] * rstd + bv[bj][1];
#pragma unroll
                    for (int e = 0; e < 4; ++e) { const float a = fmaxf(v0[e], 0.f), b = fmaxf(v1[e], 0.f); v0[e] = a * a; v1[e] = b * b; }
                    u32x4 w; w.x = cvt_pk_bf16(v0[0], v0[1]); w.y = cvt_pk_bf16(v0[2], v0[3]); w.z = cvt_pk_bf16(v1[0], v1[1]); w.w = cvt_pk_bf16(v1[2], v1[3]);
                    *(u32x4*)(rowp + bj * HALF) = w; } }
    }
};
struct EpiResGate {
    static constexpr bool PERM = true, AFTER_DRAIN = false;
    bf16_t* X; const float* gate; const float* bias; float* rsq; bf16_t* Hn; const float* ng; const float* nsc; int halfm, rowoff;
    __device__ __forceinline__ void operator()(const f32x4 (&acc)[2][2][4][2], const Unit& u, int wr, int wc, int fr, int fq) const {
        const int row0 = u.pm * BM + rowoff + wr * 64 + fr; const int col0 = u.pn * BM + wc * 32 + 8 * fq;
        const int cond = cond_of_row(u.pm * BM);
        const float* g = gate + (size_t)cond * 6144;
        f32x4 gv[2][2], bv[2][2], gm[2][2];
#pragma unroll
        for (int bj = 0; bj < 2; ++bj)
#pragma unroll
            for (int n = 0; n < 2; ++n) { gv[bj][n] = *(const f32x4*)(g + col0 + bj * HALF + n * 4);
                bv[bj][n] = bias ? *(const f32x4*)(bias + col0 + bj * HALF + n * 4) : (f32x4){0.f, 0.f, 0.f, 0.f};
                if (Hn) { const f32x4 a = *(const f32x4*)(ng + col0 + bj * HALF + n * 4), c = *(const f32x4*)(nsc + (size_t)cond * 6144 + col0 + bj * HALF + n * 4); gm[bj][n] = a * (c + 1.f); }
                else gm[bj][n] = (f32x4){0.f, 0.f, 0.f, 0.f}; }
#pragma unroll
        for (int ai = 0; ai < 2; ++ai) { if (halfm && ai == 1) break;
#pragma unroll
            for (int m = 0; m < 4; ++m) { const int row = row0 + ai * HALF + m * 16; bf16_t* rowp = X + (size_t)row * 1024 + col0; float ss = 0.f;
#pragma unroll
                for (int bj = 0; bj < 2; ++bj) { u32x4* p = (u32x4*)(rowp + bj * HALF); const u32x4 xb = *p;
                    const f32x4 xo0 = (f32x4){__builtin_bit_cast(float, xb.x << 16), __builtin_bit_cast(float, xb.x & 0xffff0000u), __builtin_bit_cast(float, xb.y << 16), __builtin_bit_cast(float, xb.y & 0xffff0000u)};
                    const f32x4 xo1 = (f32x4){__builtin_bit_cast(float, xb.z << 16), __builtin_bit_cast(float, xb.z & 0xffff0000u), __builtin_bit_cast(float, xb.w << 16), __builtin_bit_cast(float, xb.w & 0xffff0000u)};
                    const f32x4 xn0 = xo0 + gv[bj][0] * (acc[ai][bj][m][0] + bv[bj][0]), xn1 = xo1 + gv[bj][1] * (acc[ai][bj][m][1] + bv[bj][1]);
                    { u32x4 xw; xw.x = cvt_pk_bf16(xn0[0], xn0[1]); xw.y = cvt_pk_bf16(xn0[2], xn0[3]); xw.z = cvt_pk_bf16(xn1[0], xn1[1]); xw.w = cvt_pk_bf16(xn1[2], xn1[3]); *p = xw; }
                    ss += ((xn0[0] * xn0[0] + xn0[1] * xn0[1]) + (xn0[2] * xn0[2] + xn0[3] * xn0[3])) + ((xn1[0] * xn1[0] + xn1[1] * xn1[1]) + (xn1[2] * xn1[2] + xn1[3] * xn1[3]));
                    if (Hn) { const f32x4 h0 = xn0 * gm[bj][0], h1 = xn1 * gm[bj][1]; u32x4 w; w.x = cvt_pk_bf16(h0[0], h0[1]); w.y = cvt_pk_bf16(h0[2], h0[3]); w.z = cvt_pk_bf16(h1[0], h1[1]); w.w = cvt_pk_bf16(h1[2], h1[3]);
                        *(u32x4*)(Hn + (size_t)row * 1024 + col0 + bj * HALF) = w; } }
                ss += __shfl_xor(ss, 16); ss += __shfl_xor(ss, 32);
                if (fq == 0) unsafeAtomicAdd(rsq + row, ss); } }
    }
};

template <class Epi, class Sched, bool ALIGN_EPI = false, bool SP2 = false, bool HALFM = false>
__device__ __forceinline__ void gemm_phase(PG8_LAS unsigned char* lds, const Gemm g, const Sched& S, const Epi& E) {
    const int tid = opaque_tid(), wid = __builtin_amdgcn_readfirstlane(tid >> 6), lane = tid & 63, wr = wid >> 2, wc = wid & 3, fr = lane & 15, fq = lane >> 4;
    const int K = g.K, nt = K / BK;
    unsigned voffA[2], voffB[2];
#pragma unroll
    for (int i = 0; i < 2; ++i) { int R, C; stage_rc(tid * 16 + i * 8192, R, C); const int Rb = Epi::PERM ? ((R & ~31) + perm32(R & 31)) : R;
        voffA[i] = (unsigned)(R * K + C) * 2u; voffB[i] = (unsigned)(Rb * K + C) * 2u; }
    const size_t kstep = (size_t)(BK * 2);
    const size_t hstep = (size_t)HALF * K * 2;
    const size_t tstep = 2 * hstep;
    const unsigned ldsw = (unsigned)wid * 1024u;
    const int aoff = lds_byte(wr * 64 + fr, fq * 8), boff = lds_byte(wc * 32 + fr, fq * 8);
#define PG8_SA(b, h) (((b) * 2 + (h)) * HTB)
#define PG8_SB(b, h) ((4 + (b) * 2 + (h)) * HTB)
#define PG8_STAGE(bufoff, gbase, voff) do { _Pragma("unroll") for (int _i = 0; _i < 2; ++_i) \
        __builtin_amdgcn_global_load_lds((const unsigned*)((const char*)(gbase) + (voff)[_i]), (PG8_LAS unsigned*)(lds + (bufoff) + ldsw + _i * 8192), 16, 0, 0); } while (0)
#define PG8_LDA(dst, b, h) do { _Pragma("unroll") for (int m = 0; m < 4; ++m) _Pragma("unroll") for (int k = 0; k < 2; ++k) dst[m][k] = *(const PG8_LAS bf16x8*)(lds + PG8_SA(b, h) + aoff + m * 2048 + k * 1024); } while (0)
#define PG8_LDB(dst, b, h) do { _Pragma("unroll") for (int n = 0; n < 2; ++n) _Pragma("unroll") for (int k = 0; k < 2; ++k) dst[n][k] = *(const PG8_LAS bf16x8*)(lds + PG8_SB(b, h) + boff + n * 2048 + k * 1024); } while (0)
#define PG8_MMA(ai, bj, At, Bt) do { __builtin_amdgcn_s_setprio(1); _Pragma("unroll") for (int m = 0; m < 4; ++m) _Pragma("unroll") for (int n = 0; n < 2; ++n) _Pragma("unroll") for (int k = 0; k < 2; ++k) \
        acc[ai][bj][m][n] = __builtin_amdgcn_mfma_f32_16x16x32_bf16(Bt[n][k], At[m][k], acc[ai][bj][m][n], 0, 0, 0); __builtin_amdgcn_s_setprio(0); } while (0)
#define PG8_WAIT_V(n) asm volatile("s_waitcnt vmcnt(" #n ")" ::: "memory")
#define PG8_WAIT_L(n) asm volatile("s_waitcnt lgkmcnt(" #n ")" ::: "memory")
#define PG8_BAR __builtin_amdgcn_s_barrier()
#define PG8_SCHED __builtin_amdgcn_sched_barrier(0)
    Unit cur, nxt; int ui = 0;
    if (!S.next(0, cur)) return;
    f32x4 acc[2][2][4][2];
#pragma unroll
    for (int a = 0; a < 2; ++a)
#pragma unroll
        for (int b = 0; b < 2; ++b)
#pragma unroll
            for (int m = 0; m < 4; ++m)
#pragma unroll
                for (int n = 0; n < 2; ++n) acc[a][b][m][n] = (f32x4){0.f, 0.f, 0.f, 0.f};
    bf16x8 At[4][2], B0[2][2], B1[2][2];
    const char* cA = (const char*)g.A + (size_t)cur.pm * tstep; const char* cB = (const char*)g.Bt + (size_t)cur.pn * tstep;
    S.a_ready(cur);
    if constexpr (SP2) {
        PG8_STAGE(PG8_SB(0, 0), cB, voffB); PG8_STAGE(PG8_SB(0, 1), cB + hstep, voffB); PG8_STAGE(PG8_SA(0, 0), cA, voffA); PG8_STAGE(PG8_SA(0, 1), cA + hstep, voffA);
        if (wr == 1) PG8_BAR;
        PG8_WAIT_V(2); PG8_BAR;
        PG8_STAGE(PG8_SB(1, 0), cB + kstep, voffB); PG8_STAGE(PG8_SA(1, 0), cA + kstep, voffA); PG8_STAGE(PG8_SB(1, 1), cB + hstep + kstep, voffB);
        PG8_WAIT_V(6); PG8_BAR;
    } else {
        PG8_STAGE(PG8_SB(0, 0), cB, voffB); PG8_STAGE(PG8_SA(0, 0), cA, voffA); PG8_STAGE(PG8_SB(0, 1), cB + hstep, voffB); PG8_STAGE(PG8_SA(0, 1), cA + hstep, voffA);
        if (wr == 1) PG8_BAR;
        PG8_WAIT_V(4); PG8_BAR;
        PG8_STAGE(PG8_SB(1, 0), cB + kstep, voffB); PG8_STAGE(PG8_SA(1, 0), cA + kstep, voffA); PG8_STAGE(PG8_SB(1, 1), cB + hstep + kstep, voffB);
        PG8_WAIT_V(6); PG8_BAR;
    }
    for (;;) {
        const bool has_next = S.next(ui + 1, nxt);
        const char* nA = has_next ? (const char*)g.A + (size_t)nxt.pm * tstep : cA; const char* nB = has_next ? (const char*)g.Bt + (size_t)nxt.pn * tstep : cB;
        for (int t = 0; t < nt; t += 2) {
            const bool last = (t == nt - 2);
            const char* a1 = cA + (size_t)(t + 1) * kstep;
            const char* a2 = last ? nA : cA + (size_t)(t + 2) * kstep; const char* b2 = last ? nB : cB + (size_t)(t + 2) * kstep;
            const char* a3 = a2 + kstep; const char* b3 = b2 + kstep;
            if (last && has_next) S.a_ready(nxt);
            if constexpr (SP2) {
            PG8_LDB(B0, 0, 0); PG8_LDB(B1, 0, 1); PG8_SCHED; PG8_LDA(At, 0, 0); PG8_STAGE(PG8_SA(1, 1), a1 + hstep, voffA);
            PG8_WAIT_V(8); PG8_WAIT_L(0); PG8_BAR; PG8_MMA(0, 0, At, B0); PG8_MMA(0, 1, At, B1); PG8_BAR; PG8_SCHED;
            if constexpr (!HALFM) { PG8_LDA(At, 0, 1); } PG8_STAGE(PG8_SB(0, 0), b2, voffB); PG8_STAGE(PG8_SB(0, 1), b2 + hstep, voffB); PG8_STAGE(PG8_SA(0, 0), a2, voffA);
            PG8_WAIT_V(8); PG8_WAIT_L(0); PG8_BAR; if constexpr (!HALFM) { PG8_MMA(1, 0, At, B0); PG8_MMA(1, 1, At, B1); } PG8_BAR; PG8_SCHED;
            PG8_LDB(B0, 1, 0); PG8_LDB(B1, 1, 1); PG8_SCHED; PG8_LDA(At, 1, 0); PG8_STAGE(PG8_SA(0, 1), a2 + hstep, voffA);
            PG8_WAIT_V(8); PG8_WAIT_L(0); PG8_BAR; PG8_MMA(0, 0, At, B0); PG8_MMA(0, 1, At, B1); PG8_BAR; PG8_SCHED;
            if constexpr (!HALFM) { PG8_LDA(At, 1, 1); } PG8_STAGE(PG8_SB(1, 0), b3, voffB); PG8_STAGE(PG8_SB(1, 1), b3 + hstep, voffB); PG8_STAGE(PG8_SA(1, 0), a3, voffA);
            PG8_WAIT_V(8); PG8_WAIT_L(0); PG8_BAR; if constexpr (!HALFM) { PG8_MMA(1, 0, At, B0); PG8_MMA(1, 1, At, B1); } PG8_BAR; PG8_SCHED;
            } else {
            PG8_LDB(B0, 0, 0); PG8_SCHED; PG8_LDA(At, 0, 0); PG8_STAGE(PG8_SA(1, 1), a1 + hstep, voffA);
            PG8_WAIT_L(8); PG8_BAR; PG8_WAIT_L(0); PG8_MMA(0, 0, At, B0); PG8_BAR; PG8_SCHED;
            PG8_LDB(B1, 0, 1); PG8_STAGE(PG8_SB(0, 0), b2, voffB);
            PG8_BAR; PG8_WAIT_L(0); PG8_MMA(0, 1, At, B1); PG8_BAR;
            PG8_LDA(At, 0, 1); PG8_STAGE(PG8_SA(0, 0), a2, voffA);
            PG8_BAR; PG8_WAIT_L(0); PG8_MMA(1, 0, At, B0); PG8_BAR; PG8_SCHED;
            PG8_STAGE(PG8_SB(0, 1), b2 + hstep, voffB);
            PG8_WAIT_V(6); PG8_BAR; PG8_MMA(1, 1, At, B1); PG8_BAR;
            PG8_LDB(B0, 1, 0); PG8_SCHED; PG8_LDA(At, 1, 0); PG8_STAGE(PG8_SA(0, 1), a2 + hstep, voffA);
            PG8_WAIT_L(8); PG8_BAR; PG8_WAIT_L(0); PG8_MMA(0, 0, At, B0); PG8_BAR; PG8_SCHED;
            PG8_LDB(B1, 1, 1); PG8_STAGE(PG8_SB(1, 0), b3, voffB);
            PG8_BAR; PG8_WAIT_L(0); PG8_MMA(0, 1, At, B1); PG8_BAR;
            PG8_LDA(At, 1, 1); PG8_STAGE(PG8_SA(1, 0), a3, voffA);
            PG8_BAR; PG8_WAIT_L(0); PG8_MMA(1, 0, At, B0); PG8_BAR; PG8_SCHED;
            PG8_STAGE(PG8_SB(1, 1), b3 + hstep, voffB);
            PG8_WAIT_V(6); PG8_BAR; PG8_MMA(1, 1, At, B1); PG8_BAR;
            }
        }
        if constexpr (ALIGN_EPI) { if (wr == 0) PG8_BAR; }
        if constexpr (!Epi::AFTER_DRAIN) { E(acc, cur, wr, wc, fr, fq); S.done(cur); }
        if (!has_next) break;
#pragma unroll
        for (int a = 0; a < 2; ++a)
#pragma unroll
            for (int b = 0; b < 2; ++b)
#pragma unroll
                for (int m = 0; m < 4; ++m)
#pragma unroll
                    for (int n = 0; n < 2; ++n) acc[a][b][m][n] = (f32x4){0.f, 0.f, 0.f, 0.f};
        cur = nxt; cA = nA; cB = nB; ++ui;
        if constexpr (ALIGN_EPI) { if (wr == 1) PG8_BAR; }
    }
    PG8_WAIT_V(0);
    if constexpr (!ALIGN_EPI) { if (wr == 0) PG8_BAR; }
    PG8_BAR;
    if constexpr (Epi::AFTER_DRAIN) { E.fused(acc, cur, wr, wc, fr, fq, lds, wid, lane); S.done(cur); }
#undef PG8_SA
#undef PG8_SB
#undef PG8_STAGE
#undef PG8_LDA
#undef PG8_LDB
#undef PG8_MMA
#undef PG8_WAIT_V
#undef PG8_WAIT_L
#undef PG8_BAR
#undef PG8_SCHED
}
}

#define LAS __attribute__((address_space(3)))
typedef unsigned short bf16_t;
typedef short bf16x8 __attribute__((ext_vector_type(8)));
typedef short s16x4 __attribute__((ext_vector_type(4)));
typedef float f32x4 __attribute__((ext_vector_type(4)));
typedef float f32x16 __attribute__((ext_vector_type(16)));
typedef unsigned u32x4 __attribute__((ext_vector_type(4)));
typedef unsigned u32x2 __attribute__((ext_vector_type(2)));

constexpr int NTOK = 24576, NCTX = 8192, DM = 1024, DFF = 4096;
constexpr float LOG2E = 1.4426950408889634f;
constexpr float RMS_EPS = 1e-6f;
constexpr size_t MiB = 1024 * 1024;
constexpr size_t WS_MODS = 0, WS_WO = 1 * MiB, WS_W1 = 9 * MiB, WS_W2 = 41 * MiB, WS_QKVA = 73 * MiB, WS_QKVB = 85 * MiB, WS_QKVC = 88 * MiB;
constexpr size_t WS_CKA = 91 * MiB, WS_CVA = 107 * MiB, WS_CKB = 123 * MiB, WS_CVB = 125 * MiB, WS_CKC = 127 * MiB, WS_CVC = 129 * MiB;
constexpr size_t WS_H = 131 * MiB, WS_QKV = 179 * MiB, WS_O = 323 * MiB, WS_U = WS_QKV, WS_ROWSQ = 371 * MiB, WS_SHW = 372 * MiB, WS_X = 374 * MiB, WS_END = 422 * MiB;
constexpr size_t OUT_X = 0, OUT_KA = 25165824, OUT_VA = 41943040, OUT_KB = 58720256, OUT_VB = 60817408, OUT_KC = 62914560, OUT_VC = 65011712;
constexpr int LDS_BYTES = 131072 + 4096;
#ifndef REP_P0
#define REP_P0 1
#endif
#ifndef REP_NORM
#define REP_NORM 1
#endif
#ifndef REP_GEMM
#define REP_GEMM 1
#endif
#ifndef REP_SYNC
#define REP_SYNC 1
#endif
#ifndef REP_ATTN
#define REP_ATTN 1
#endif

__device__ __forceinline__ unsigned f2bf(float f) { unsigned u = __builtin_bit_cast(unsigned, f); return (u + 0x7fffu + ((u >> 16) & 1u)) >> 16; }
__device__ __forceinline__ unsigned pk2(float lo, float hi) { return f2bf(lo) | (f2bf(hi) << 16); }
__device__ __forceinline__ float bf2f(unsigned short b) { return __builtin_bit_cast(float, (unsigned)b << 16); }
__device__ __forceinline__ float wave_sum(float v) {
#pragma unroll
    for (int o = 1; o < 64; o <<= 1) v += __shfl_xor(v, o);
    return v;
}

struct Params { const float* in[27]; float* out; unsigned char* ws; int ph_lo, ph_hi; };

#define XB_TMO      128
#define XB_XCNT(j)  (256  + 64 * (j))
#define XB_XSUB(j)  (1280 + 64 * (j))
#define XB_XGEN(j)  (2304 + 64 * (j))
#define XB_TOP      3328
#define XB_TOPGEN   3392
#define XCD_BAR_WORDS 3456
#define XB_SPIN_CAP (1u << 18)

__device__ __forceinline__ unsigned xb_ld(unsigned* p)              { return __hip_atomic_load(p, __ATOMIC_RELAXED, __HIP_MEMORY_SCOPE_AGENT); }
__device__ __forceinline__ unsigned xb_add(unsigned* p, unsigned v) { return __hip_atomic_fetch_add(p, v, __ATOMIC_RELAXED, __HIP_MEMORY_SCOPE_AGENT); }
__device__ __forceinline__ unsigned xb_xcc_id() { return (unsigned)__builtin_amdgcn_s_getreg((3 << 11) | 20) & 0xFu; }
#define XB_SPIN(cond, bar) do { unsigned _sp = 0; while (cond) { __builtin_amdgcn_s_sleep(1); \
    if ((++_sp & 255u) == 0u) { if (xb_ld(&(bar)[XB_TMO])) break; if (_sp > XB_SPIN_CAP) { atomicAdd(&(bar)[XB_TMO], 1u); break; } } } } while (0)

struct XcdBarrier {
    unsigned* bar; unsigned x;
    volatile LAS unsigned* st;
};

__device__ __forceinline__ XcdBarrier xcd_barrier_post(unsigned* bar, volatile LAS unsigned* st) {
    XcdBarrier b; b.bar = bar; b.x = xb_xcc_id(); b.st = st;
    if (threadIdx.x == 0) (void)xb_add(&bar[XB_XCNT(b.x)], 1u);
    return b;
}
__device__ __forceinline__ void xcd_barrier_complete(unsigned* bar, unsigned x, unsigned& nloc, unsigned& nx) {
    const unsigned G = gridDim.x * gridDim.y * gridDim.z;
    unsigned sum, cnt, mine, sp = 0u;
    for (;;) {
        sum = 0u; cnt = 0u; mine = 0u;
#pragma unroll
        for (unsigned j = 0; j < 16; ++j) { const unsigned c = xb_ld(&bar[XB_XCNT(j)]); sum += c; cnt += (c > 0u) ? 1u : 0u; mine = (j == x) ? c : mine; }
        if (sum == G) break;
        __builtin_amdgcn_s_sleep(1);
        if ((++sp & 255u) == 0u) { if (xb_ld(&bar[XB_TMO])) break; if (sp > XB_SPIN_CAP) { atomicAdd(&bar[XB_TMO], 1u); break; } }
    }
    nloc = mine > 0u ? mine : 1u; nx = cnt > 0u ? cnt : 1u;
}

__device__ __forceinline__ void xcd_barrier(const XcdBarrier& b) {
    asm volatile("s_waitcnt vmcnt(0)" ::: "memory");
    __syncthreads();
    if (threadIdx.x == 0) {
        unsigned* bar = b.bar;
        __builtin_amdgcn_s_waitcnt(0);
        unsigned nloc = b.st[0], nx = b.st[1];
        if (nloc == 0u) { xcd_barrier_complete(bar, b.x, nloc, nx); b.st[0] = nloc; b.st[1] = nx; }
        const unsigned old = xb_add(&bar[XB_XSUB(b.x)], 1u);
        const unsigned gen = old / nloc;
        if (old + 1u == (gen + 1u) * nloc) {
            __builtin_amdgcn_fence(__ATOMIC_RELEASE, "agent");
            asm volatile("s_waitcnt vmcnt(0)" ::: "memory");
            const unsigned og = xb_add(&bar[XB_TOP], 1u);
            const unsigned tg = og / nx;
            if (og + 1u == (tg + 1u) * nx) xb_add(&bar[XB_TOPGEN], 1u);
            else XB_SPIN(xb_ld(&bar[XB_TOPGEN]) == tg, bar);
            __builtin_amdgcn_fence(__ATOMIC_ACQUIRE, "agent");
            xb_add(&bar[XB_XGEN(b.x)], 1u);
            asm volatile("s_waitcnt vmcnt(0)" ::: "memory");
        } else {
            XB_SPIN(xb_ld(&bar[XB_XGEN(b.x)]) == gen, bar);
            __builtin_amdgcn_fence(__ATOMIC_ACQUIRE, "agent");
            asm volatile("s_waitcnt vmcnt(0)" ::: "memory");
        }
    }
    __syncthreads();
}

constexpr size_t WS_BAR = 917504;

__device__ __forceinline__ void transpose_item(const float* W, int K, int N, bf16_t* WT, LAS float* scr, int item, int lane) {
    const int nblk = N / 32, kb = item / nblk, nb = item % nblk, k0 = 64 * kb, n0 = 32 * nb;
    { f32x4 v[8];
#pragma unroll
      for (int i = 0; i < 8; ++i) v[i] = *(const f32x4*)(W + (size_t)(k0 + 8 * i + (lane >> 3)) * N + n0 + 4 * (lane & 7));
#pragma unroll
      for (int i = 0; i < 8; ++i) { LAS float* d = scr + (8 * i + (lane >> 3)) * 33 + 4 * (lane & 7); d[0] = v[i][0]; d[1] = v[i][1]; d[2] = v[i][2]; d[3] = v[i][3]; } }
    asm volatile("s_waitcnt lgkmcnt(0)" ::: "memory");
    const int c = lane & 7;
#pragma unroll
    for (int j = 0; j < 4; ++j) { const int n = (lane >> 3) + 8 * j; const LAS float* s = scr + (8 * c) * 33 + n;
        u32x4 o; o.x = pk2(s[0 * 33], s[1 * 33]); o.y = pk2(s[2 * 33], s[3 * 33]); o.z = pk2(s[4 * 33], s[5 * 33]); o.w = pk2(s[6 * 33], s[7 * 33]);
        *(u32x4*)(WT + (size_t)(n0 + n) * K + k0 + 8 * c) = o; }
    asm volatile("s_waitcnt lgkmcnt(0)" ::: "memory");
}
__device__ __forceinline__ void transpose_matrix(const float* W, int K, int N, bf16_t* WT, LAS float* scr, int gw, int ngw, int lane) {
    const int items = (K / 64) * (N / 32);
    for (int it = gw; it < items; it += ngw) transpose_item(W, K, N, WT, scr, it, lane);
}
__device__ __forceinline__ void convert_array(const float* src, bf16_t* dst, size_t n4, size_t gt, size_t ngt) {
    for (size_t i = gt; i < n4; i += ngt) { const f32x4 v = ((const f32x4*)src)[i]; u32x2 o; o.x = pk2(v[0], v[1]); o.y = pk2(v[2], v[3]); ((u32x2*)dst)[i] = o; }
}

__device__ __forceinline__ void gemv9_item(const LAS float* sc, LAS float* part, const float* W, int ldw, const float* bias, float* out, int ldo, int n0, int tid) {
    const int n = n0 + (tid & 127), kq = tid >> 7;
    const float* Wp = W + (size_t)(kq * 256) * ldw + n;
    float acc[9];
#pragma unroll
    for (int c = 0; c < 9; ++c) acc[c] = 0.f;
    for (int k0 = 0; k0 < 256; k0 += 16) {
        float w[16];
#pragma unroll
        for (int i = 0; i < 16; ++i) w[i] = Wp[(size_t)(k0 + i) * ldw];
#pragma unroll
        for (int i = 0; i < 16; ++i)
#pragma unroll
            for (int c = 0; c < 9; ++c) acc[c] += sc[c * 1024 + kq * 256 + k0 + i] * w[i];
    }
#pragma unroll
    for (int c = 0; c < 9; ++c) part[(kq * 128 + (tid & 127)) * 9 + c] = acc[c];
    __syncthreads();
    if (kq == 0) {
        const float bz = bias ? bias[n] : 0.f;
#pragma unroll
        for (int c = 0; c < 9; ++c) { const float v = part[(0 * 128 + tid) * 9 + c] + part[(1 * 128 + tid) * 9 + c] + part[(2 * 128 + tid) * 9 + c] + part[(3 * 128 + tid) * 9 + c];
            out[(size_t)c * ldo + n] = v + bz; }
    }
    __syncthreads();
}
typedef const __attribute__((address_space(4))) Params* KP;
__device__ __forceinline__ void mods_phase(KP Pq, LAS unsigned char* lds) {
    const float* const in8 = Pq->in[8]; const float* const in9 = Pq->in[9]; const float* const in10 = Pq->in[10]; const float* const in11 = Pq->in[11]; unsigned char* const wsb = Pq->ws;
    LAS float* sc = (LAS float*)lds; LAS float* part = (LAS float*)(lds + 36864);
    const int tid = opaque_tid(); const int bid = opaque_bid();
    if (bid >= 192) return;
    for (int i = tid; i < 9 * 1024; i += 512) { const float v = i < 8192 ? in8[i] : in9[i - 8192]; sc[i] = v / (1.f + __expf(-v)); }
    __syncthreads();
    const int l = bid / 48, n0 = (bid % 48) * 128;
    gemv9_item(sc, part, in10 + (size_t)l * 1024 * 6144, 6144, in11 + l * 6144, (float*)(wsb + WS_MODS) + (size_t)l * 9 * 6144, 6144, n0, tid);
}
__device__ __forceinline__ void shw_phase(KP Pq, LAS unsigned char* lds) {
    LAS float* sc = (LAS float*)lds; LAS float* part = (LAS float*)(lds + 36864);
    const int tid = opaque_tid(); const int bid = opaque_bid();
    if (bid >= 200) return;
    int it = bid, l = 0;
    for (;;) { const int cnt = ((l % 3) == 0 ? 24 : 12) + 32; if (it < cnt) break; it -= cnt; ++l; }
    const int mix = l % 3, j = l / 3, nq = (mix == 0 ? 24 : 12);
    const bool isq = it < nq; const int n0 = (isq ? it : it - nq) * 128;
    const float* mods = (const float*)(Pq->ws + WS_MODS) + (size_t)l * 9 * 6144 + (isq ? 0 : 3 * 1024);
    for (int i = tid; i < 9 * 1024; i += 512) sc[i] = mods[(size_t)(i >> 10) * 6144 + (i & 1023)];
    __syncthreads();
    float* out = (float*)(Pq->ws + WS_SHW) + (size_t)(2 * l + (isq ? 0 : 1)) * 9 * 4096;
    if (isq) { const int nqkv = mix == 0 ? 3072 : 1536; const float* W = mix == 0 ? Pq->in[19] + (size_t)j * 1024 * 3072 : (mix == 1 ? Pq->in[21] : Pq->in[23]);
        gemv9_item(sc, part, W, nqkv, nullptr, out, nqkv, n0, tid); }
    else gemv9_item(sc, part, Pq->in[15] + (size_t)l * 1024 * 4096, 4096, Pq->in[16] + l * 4096, out, 4096, n0, tid);
}

__device__ __forceinline__ void xin_phase(const float* xp, const float* xs, bf16_t* X, bf16_t* H, float* rowsq0, const float* g, const float* mods0) {
    const int tid_ = opaque_tid(); const int lane = tid_ & 63, gw = opaque_bid() * 8 + (tid_ >> 6), ngw = gridDim.x * 8;
    f32x4 gv[4];
#pragma unroll
    for (int j = 0; j < 4; ++j) gv[j] = ((const f32x4*)g)[lane + 64 * j];
    for (int row = gw; row < NTOK; row += ngw) {
        const f32x4* xr = (const f32x4*)(row < NCTX ? xp + (size_t)row * DM : xs + (size_t)(row - NCTX) * DM) + lane;
        f32x4 v[4]; float s = 0.f;
#pragma unroll
        for (int j = 0; j < 4; ++j) { v[j] = xr[64 * j]; s += (v[j][0] * v[j][0] + v[j][1] * v[j][1]) + (v[j][2] * v[j][2] + v[j][3] * v[j][3]); }
        s = wave_sum(s);
        if (lane == 0) rowsq0[row] = s;
        const float* mc = mods0 + (size_t)pg8::cond_of_row(row) * 6144 + 1024;
        u32x2* xo = (u32x2*)(X + (size_t)row * DM) + lane; u32x2* o8 = (u32x2*)(H + (size_t)row * DM) + lane;
#pragma unroll
        for (int j = 0; j < 4; ++j) { const f32x4 sc = ((const f32x4*)mc)[lane + 64 * j]; const f32x4 y = v[j] * gv[j] * (sc + 1.f);
            u32x2 xb; xb.x = pk2(v[j][0], v[j][1]); xb.y = pk2(v[j][2], v[j][3]); xo[64 * j] = xb; u32x2 o; o.x = pk2(y[0], y[1]); o.y = pk2(y[2], y[3]); o8[64 * j] = o; }
    }
}

__device__ __forceinline__ void norm_mod_phase(const float* X, bf16_t* H, const float* g, const float* mods_l, int ch_sh, int ch_sc) {
    const int tid_ = opaque_tid(); const int lane = tid_ & 63, gw = opaque_bid() * 8 + (tid_ >> 6), ngw = gridDim.x * 8;
    f32x4 gv[4];
#pragma unroll
    for (int j = 0; j < 4; ++j) gv[j] = ((const f32x4*)g)[lane + 64 * j];
    for (int row = gw; row < NTOK; row += ngw) {
        const f32x4* xr = (const f32x4*)(X + (size_t)row * DM) + lane;
        f32x4 v[4]; float s = 0.f;
#pragma unroll
        for (int j = 0; j < 4; ++j) { v[j] = xr[64 * j]; s += (v[j][0] * v[j][0] + v[j][1] * v[j][1]) + (v[j][2] * v[j][2] + v[j][3] * v[j][3]); }
        const float rstd = rsqrtf(wave_sum(s) * (1.f / DM) + RMS_EPS);
        const float* mc = mods_l + (size_t)pg8::cond_of_row(row) * 6144;
        u32x2* o8 = (u32x2*)(H + (size_t)row * DM) + lane;
#pragma unroll
        for (int j = 0; j < 4; ++j) { const f32x4 sh = ((const f32x4*)(mc + ch_sh * 1024))[lane + 64 * j], sc = ((const f32x4*)(mc + ch_sc * 1024))[lane + 64 * j];
            f32x4 y;
#pragma unroll
            for (int e = 0; e < 4; ++e) y[e] = (v[j][e] * rstd * gv[j][e]) * (1.f + sc[e]) + sh[e];
            u32x2 o; o.x = pk2(y[0], y[1]); o.y = pk2(y[2], y[3]); o8[64 * j] = o; }
    }
}
__device__ __forceinline__ void final_norm_phase(const bf16_t* X, float* Y, const float* g, const float* rowsq) {
    const int tid_ = opaque_tid(); const int lane = tid_ & 63, gw = opaque_bid() * 8 + (tid_ >> 6), ngw = gridDim.x * 8;
    f32x4 gv[4];
#pragma unroll
    for (int j = 0; j < 4; ++j) gv[j] = ((const f32x4*)g)[lane + 64 * j];
    for (int row = gw; row < NTOK; row += ngw) {
        const u32x2* xr = (const u32x2*)(X + (size_t)row * DM) + lane; f32x4* yr = (f32x4*)(Y + (size_t)row * DM) + lane;
        const float rstd = rsqrtf(rowsq[row] * (1.f / DM) + RMS_EPS);
#pragma unroll
        for (int j = 0; j < 4; ++j) { const u32x2 b = xr[64 * j];
            const f32x4 x = (f32x4){__builtin_bit_cast(float, b.x << 16), __builtin_bit_cast(float, b.x & 0xffff0000u), __builtin_bit_cast(float, b.y << 16), __builtin_bit_cast(float, b.y & 0xffff0000u)};
            __builtin_nontemporal_store(x * rstd * gv[j], &yr[64 * j]); }
    }
}

template <int MIX>
__device__ __forceinline__ void qkfix_phase(bf16_t* QKV, const float* qn, const float* kn, float* kc_out) {
    const int tid_ = opaque_tid(); const int lane = tid_ & 63, gw = opaque_bid() * 8 + (tid_ >> 6), ngw = gridDim.x * 8;
    const int hl = lane & 31, head = hl >> 3, c = hl & 7, half = lane >> 5;
    float fr[8], g[8];
#pragma unroll
    for (int j = 0; j < 8; ++j) { fr[j] = __builtin_amdgcn_exp2f(-13.287712379549449f * (float)(8 * (c & 1) + j) * (1.f / 16.f)) * 0.15915494309189535f; g[j] = (MIX == 2) ? kn[8 * c + j] : 1.f; }
    const float sgn = (c & 2) ? 1.f : -1.f;
    const int row_lo = (MIX == 1) ? NCTX : 0;
    for (int rowa = row_lo + 2 * gw + half; rowa < NTOK; rowa += 4 * ngw) {
        u32x4 raw[2];
#pragma unroll
        for (int t = 0; t < 2; ++t) raw[t] = *(const u32x4*)(QKV + (size_t)(rowa + t * 2 * ngw) * 1536 + 1024 + head * 64 + 8 * c);
#pragma unroll
        for (int t = 0; t < 2; ++t) { const int row = rowa + t * 2 * ngw; const bool lat = row >= NCTX; const int tt = (row - NCTX) & 2047;
            float x[8];
            x[0] = __builtin_bit_cast(float, raw[t].x << 16); x[1] = __builtin_bit_cast(float, raw[t].x & 0xffff0000u); x[2] = __builtin_bit_cast(float, raw[t].y << 16); x[3] = __builtin_bit_cast(float, raw[t].y & 0xffff0000u);
            x[4] = __builtin_bit_cast(float, raw[t].z << 16); x[5] = __builtin_bit_cast(float, raw[t].z & 0xffff0000u); x[6] = __builtin_bit_cast(float, raw[t].w << 16); x[7] = __builtin_bit_cast(float, raw[t].w & 0xffff0000u);
            if (MIX == 2) {
                float ss = 0.f;
#pragma unroll
                for (int j = 0; j < 8; ++j) ss += x[j] * x[j];
                ss += __shfl_xor(ss, 1); ss += __shfl_xor(ss, 2); ss += __shfl_xor(ss, 4);
                const float rstd = rsqrtf(ss * (1.f / 64.f) + RMS_EPS);
#pragma unroll
                for (int j = 0; j < 8; ++j) x[j] = x[j] * rstd * g[j];
                if (!lat) { float* ko = kc_out + (size_t)row * 256 + head * 64 + 8 * c; __builtin_nontemporal_store((f32x4){x[0], x[1], x[2], x[3]}, (f32x4*)ko); __builtin_nontemporal_store((f32x4){x[4], x[5], x[6], x[7]}, (f32x4*)(ko + 4)); }
            }
            if (lat) { const float pos = (float)(c < 4 ? (tt >> 6) : (tt & 63));
#pragma unroll
                for (int j = 0; j < 8; ++j) { const float a = pos * fr[j], cs = __builtin_amdgcn_cosf(a), sn = __builtin_amdgcn_sinf(a); const float xp = __shfl_xor(x[j], 2); x[j] = x[j] * cs + sgn * xp * sn; } }
            if (lat || MIX == 2) { u32x4 o; o.x = pk2(x[0], x[1]); o.y = pk2(x[2], x[3]); o.z = pk2(x[4], x[5]); o.w = pk2(x[6], x[7]);
                *(u32x4*)(QKV + (size_t)row * 1536 + 1024 + head * 64 + 8 * c) = o; } }
    }
}

constexpr float AT_THRL = 8.f;
constexpr int AT_KP = 144, AT_VP = 192, AT_KT = 64 * AT_KP, AT_VT = 64 * AT_VP, AT_BUF = AT_KT + AT_VT, AT_RPB = 3 * AT_BUF, AT_OST = 3 * AT_BUF + 4096;
__device__ __forceinline__ s16x4 vtr(const LAS unsigned char* p) {
    typedef short v4i16_t __attribute__((ext_vector_type(4)));
    return __builtin_bit_cast(s16x4, __builtin_amdgcn_ds_read_tr16_b64_v4i16((LAS v4i16_t*)p));
}
__device__ __forceinline__ unsigned cvtpk(float lo, float hi) { unsigned r; asm volatile("v_cvt_pk_bf16_f32 %0, %1, %2" : "=v"(r) : "v"(lo), "v"(hi)); return r; }

template <int MIX>
__device__ __forceinline__ void attn_phase(LAS unsigned char* lds, const bf16_t* QKV, int ldq, int nkv, const bf16_t* CK, const bf16_t* CV, size_t cbstride,
                                           const float* rpb, const float* sink, const float* qn, bf16_t* O) {
    const int tid = opaque_tid(), wid = __builtin_amdgcn_readfirstlane(tid >> 6), lane = tid & 63, ql = lane & 31, hi = lane >> 5; const int bid = opaque_bid();
    const int G = 16 / nkv, nk = nkv * 64;
    const int lrow = tid >> 3, lch = tid & 7;
    const float C2 = 0.125f * LOG2E;
    LAS float* rpbL = (LAS float*)(lds + AT_RPB) + 64;
    const int g16 = lane >> 4, i16 = lane & 15;
    const int vtr_off = (4 * hi + (i16 >> 2)) * AT_VP + (16 * (g16 & 1) + 4 * (i16 & 3)) * 2;
    for (int u = bid; u < 1536; u += gridDim.x) {
        const bool lat = u < 1024;
        int b, h, qb;
        if (lat) { const int k_ = u >> 8, x_ = u & 7, sl_ = (u & 255) >> 3; b = 2 * k_ + (x_ >> 2); h = (x_ & 3) * 4 + (sl_ >> 3); qb = sl_ & 7; }   else { const int uu = u - 1024; b = uu >> 4; h = uu & 15; qb = 0; }
        const int kvh = h / G;
        const size_t qrow0 = lat ? (size_t)NCTX + b * 2048 + qb * 256 : (size_t)b * 256;
        const size_t lrow0 = lat ? (size_t)NCTX + b * 2048 : (size_t)b * 256;
        int lo, hiT; const int nctx = lat ? 8 : 0;
        if (!lat) { lo = 0; hiT = 3; }
        else if (MIX == 0) { lo = max(4 * qb - 4, 0); hiT = min(max(4 * qb - 1, 0), 24) + 7; }
        else if (MIX == 1) { lo = max(0, 4 * qb - 2); hiT = min(31, 4 * qb + 5); }
        else { lo = 0; hiT = 31; }
        const int nt = nctx + hiT - lo + 1;
        const bf16_t* ckb = CK + (size_t)b * cbstride + kvh * 64; const bf16_t* cvb = CV + (size_t)b * cbstride + kvh * 64;
        const bf16_t* lkb = QKV + lrow0 * ldq + 1024 + kvh * 64; const bf16_t* lvb = lkb + nk;
        bf16x8 qf[4];
        { const bf16_t* qp = QKV + (qrow0 + 32 * wid + ql) * ldq + h * 64 + 8 * hi;
#pragma unroll
          for (int s = 0; s < 4; ++s) qf[s] = *(const bf16x8*)(qp + 16 * s); }
        if (MIX != 0) {
            float qv[4][8];
#pragma unroll
            for (int s = 0; s < 4; ++s)
#pragma unroll
                for (int j = 0; j < 8; ++j) qv[s][j] = bf2f((unsigned short)qf[s][j]);
            if (MIX == 2) {
                float ss = 0.f;
#pragma unroll
                for (int s = 0; s < 4; ++s)
#pragma unroll
                    for (int j = 0; j < 8; ++j) ss += qv[s][j] * qv[s][j];
                ss += __shfl_xor(ss, 32);
                const float rstd = rsqrtf(ss * (1.f / 64.f) + RMS_EPS);
#pragma unroll
                for (int s = 0; s < 4; ++s)
#pragma unroll
                    for (int j = 0; j < 8; ++j) qv[s][j] = qv[s][j] * rstd * qn[16 * s + 8 * hi + j];
            }
            if (lat) {
                const int t = (int)(qrow0 + 32 * wid + ql - NCTX) & 2047; const float rp = (float)(t >> 6), cp = (float)(t & 63);
#pragma unroll
                for (int j = 0; j < 8; ++j) {
                    const float fr = __builtin_amdgcn_exp2f(-13.287712379549449f * (float)(8 * hi + j) * (1.f / 16.f)) * 0.15915494309189535f;
                    const float c1 = __builtin_amdgcn_cosf(rp * fr), s1 = __builtin_amdgcn_sinf(rp * fr), c2 = __builtin_amdgcn_cosf(cp * fr), s2 = __builtin_amdgcn_sinf(cp * fr);
                    const float a1 = qv[0][j], a2 = qv[1][j], b1 = qv[2][j], b2 = qv[3][j];
                    qv[0][j] = a1 * c1 - a2 * s1; qv[1][j] = a2 * c1 + a1 * s1; qv[2][j] = b1 * c2 - b2 * s2; qv[3][j] = b2 * c2 + b1 * s2;
                }
            }
#pragma unroll
            for (int s = 0; s < 4; ++s) { u32x4 w; w.x = cvtpk(qv[s][0] * C2, qv[s][1] * C2); w.y = cvtpk(qv[s][2] * C2, qv[s][3] * C2); w.z = cvtpk(qv[s][4] * C2, qv[s][5] * C2); w.w = cvtpk(qv[s][6] * C2, qv[s][7] * C2); qf[s] = __builtin_bit_cast(bf16x8, w); }
        } else {
#pragma unroll
            for (int s = 0; s < 4; ++s) { u32x4 w; w.x = cvtpk(bf2f((unsigned short)qf[s][0]) * C2, bf2f((unsigned short)qf[s][1]) * C2); w.y = cvtpk(bf2f((unsigned short)qf[s][2]) * C2, bf2f((unsigned short)qf[s][3]) * C2);
                w.z = cvtpk(bf2f((unsigned short)qf[s][4]) * C2, bf2f((unsigned short)qf[s][5]) * C2); w.w = cvtpk(bf2f((unsigned short)qf[s][6]) * C2, bf2f((unsigned short)qf[s][7]) * C2); qf[s] = __builtin_bit_cast(bf16x8, w); }
        }
        float mhat = 0.f, l = 0.f;
        f32x16 O0, O1;
#pragma unroll
        for (int r = 0; r < 16; ++r) { O0[r] = 0.f; O1[r] = 0.f; }
        const int rq = 4 * qb + (wid >> 1), r0 = min(max(rq - 4, 0), 24);
        const int cq = 32 * (wid & 1) + ql, c0 = min(max(cq - 8, 0), 48);
        const int qw0 = 256 * qb + 32 * wid, tq = qw0 + ql;
        u32x4 kA, vA;
#define AT_LOAD(i, KR, VR) do { const int _i = (i); int _t_ = tid; asm volatile("" : "+v"(_t_)); const int _lr = _t_ >> 3, _lc = _t_ & 7; \
        if (_i < nctx) { const size_t _t = (size_t)_i * 64 * nk * 2; const unsigned _o = (unsigned)(_lr * nk + _lc * 8) * 2u; KR = *(const u32x4*)((const char*)ckb + _t + _o); VR = *(const u32x4*)((const char*)cvb + _t + _o); } \
        else { const size_t _t = (size_t)(lo + _i - nctx) * 64 * ldq * 2; const unsigned _o = (unsigned)(_lr * ldq + _lc * 8) * 2u; KR = *(const u32x4*)((const char*)lkb + _t + _o); VR = *(const u32x4*)((const char*)lvb + _t + _o); } } while (0)
#define AT_STORE(bufi, KR, VR) do { int _t_ = tid; asm volatile("" : "+v"(_t_)); const int _lr = _t_ >> 3, _lc = _t_ & 7; LAS unsigned char* _b = lds + (bufi) * AT_BUF; \
        *(LAS u32x4*)(_b + _lr * AT_KP + _lc * 16) = KR; *(LAS u32x4*)(_b + AT_KT + _lr * AT_VP + _lc * 16) = VR; } while (0)
#define AT_KLOAD(slot, h_) do { const LAS unsigned char* _kb = lds + (slot) * AT_BUF + ql * AT_KP + hi * 16 + (h_) * 64; \
        _Pragma("unroll") for (int _s = 0; _s < 2; ++_s) { ka[_s] = *(const LAS bf16x8*)(_kb + _s * 32); kc[_s] = *(const LAS bf16x8*)(_kb + 32 * AT_KP + _s * 32); } } while (0)
#define AT_QK0(N0, N1) do { N0 = __builtin_amdgcn_mfma_f32_32x32x16_bf16(ka[0], qf[0], negm, 0, 0, 0); N1 = __builtin_amdgcn_mfma_f32_32x32x16_bf16(kc[0], qf[0], negm, 0, 0, 0); } while (0)
#define AT_QKSTEP(_s, N0, N1) do { N0 = __builtin_amdgcn_mfma_f32_32x32x16_bf16(ka[(_s) & 1], qf[_s], N0, 0, 0, 0); N1 = __builtin_amdgcn_mfma_f32_32x32x16_bf16(kc[(_s) & 1], qf[_s], N1, 0, 0, 0); } while (0)
#define AT_VLOAD(slot, _sb) do { const LAS unsigned char* _vb = lds + (slot) * AT_BUF + AT_KT + vtr_off; \
        _Pragma("unroll") for (int _s = 0; _s < 2; ++_s) { const LAS unsigned char* _vp = _vb + (32 * (_sb) + 16 * _s) * AT_VP; \
            const s16x4 _a0l = vtr(_vp), _a0h = vtr(_vp + 8 * AT_VP), _a1l = vtr(_vp + 64), _a1h = vtr(_vp + 64 + 8 * AT_VP); \
            vf0[_s] = (bf16x8){_a0l[0], _a0l[1], _a0l[2], _a0l[3], _a0h[0], _a0h[1], _a0h[2], _a0h[3]}; \
            vf1[_s] = (bf16x8){_a1l[0], _a1l[1], _a1l[2], _a1l[3], _a1h[0], _a1h[1], _a1h[2], _a1h[3]}; } } while (0)
#define AT_MASKMAX(ti, P0, P1) do { const int _ti = (ti); const int _lt = lo + _ti - nctx; \
        if (MIX == 0 && lat && _ti >= nctx) { const LAS float* rb_ = rpbL + ((_lt - rq + 7) * 31 + 15 - cq + 4 * hi); const bool rowok = (_lt >= r0 && _lt < r0 + 8); const int cb_ = 4 * hi - c0; \
            _Pragma("unroll") for (int r = 0; r < 16; ++r) { const int kq_ = (r & 3) + 8 * (r >> 2); const bool ok = rowok && (unsigned)(kq_ + cb_) < 16u; P0[r] = ok ? P0[r] + rb_[kq_] : -1e30f; } \
            AT_SB(); \
            _Pragma("unroll") for (int r = 0; r < 16; ++r) { const int kq_ = (r & 3) + 8 * (r >> 2) + 32; const bool ok = rowok && (unsigned)(kq_ + cb_) < 16u; P1[r] = ok ? P1[r] + rb_[kq_] : -1e30f; } } \
        else if (MIX == 1 && lat && _ti >= nctx) { const int d_ = 64 * _lt + 4 * hi - tq + 128; \
            _Pragma("unroll") for (int r = 0; r < 16; ++r) { const int kq_ = (r & 3) + 8 * (r >> 2); \
                P0[r] = ((unsigned)(kq_ + d_) <= 256u) ? P0[r] : -1e30f; P1[r] = ((unsigned)(kq_ + 32 + d_) <= 256u) ? P1[r] : -1e30f; } } \
        float mx = fmaxf(fmaxf(P0[0], P0[1]), P0[2]), mx1_ = fmaxf(fmaxf(P1[0], P1[1]), P1[2]);     \
        _Pragma("unroll") for (int r = 3; r < 15; r += 2) { mx = fmaxf(fmaxf(mx, P0[r]), P0[r + 1]); mx1_ = fmaxf(fmaxf(mx1_, P1[r]), P1[r + 1]); } \
        mx = fmaxf(fmaxf(mx, P0[15]), fmaxf(mx1_, P1[15])); \
        { const auto _rr = __builtin_amdgcn_permlane32_swap(__float_as_uint(mx), __float_as_uint(mx), false, false); mx = fmaxf(__uint_as_float(_rr[0]), __uint_as_float(_rr[1])); } \
        const bool first_ = (_ti == 0); \
        if (first_ || __builtin_amdgcn_ballot_w64(mx > AT_THRL) != 0ull) { const float dl = first_ ? mx : fmaxf(mx, 0.f); mhat += dl; \
            _Pragma("unroll") for (int r = 0; r < 16; ++r) { P0[r] -= dl; P1[r] -= dl; } \
            const float f = first_ ? 1.f : __builtin_amdgcn_exp2f(-dl); l *= f;     \
            _Pragma("unroll") for (int r = 0; r < 16; ++r) { O0[r] *= f; O1[r] *= f; } \
            _Pragma("unroll") for (int r = 0; r < 16; ++r) negm[r] = -mhat; } } while (0)
#define AT_EXP(P) do { _Pragma("unroll") for (int r = 0; r < 16; ++r) P[r] = __builtin_amdgcn_exp2f(P[r]); } while (0)
#define AT_FIN(P0, P1) do { float ls0 = 0.f, ls1 = 0.f; _Pragma("unroll") for (int r = 0; r < 16; ++r) { ls0 += P0[r]; ls1 += P1[r]; } \
        l += (ls0 + ls1); \
        _Pragma("unroll") for (int _s = 0; _s < 2; ++_s) { u32x4 w0, w1; \
            w0.x = cvtpk(P0[8 * _s + 0], P0[8 * _s + 1]); w0.y = cvtpk(P0[8 * _s + 2], P0[8 * _s + 3]); w0.z = cvtpk(P0[8 * _s + 4], P0[8 * _s + 5]); w0.w = cvtpk(P0[8 * _s + 6], P0[8 * _s + 7]); \
            w1.x = cvtpk(P1[8 * _s + 0], P1[8 * _s + 1]); w1.y = cvtpk(P1[8 * _s + 2], P1[8 * _s + 3]); w1.z = cvtpk(P1[8 * _s + 4], P1[8 * _s + 5]); w1.w = cvtpk(P1[8 * _s + 6], P1[8 * _s + 7]); \
            pf[0][_s] = __builtin_bit_cast(bf16x8, w0); pf[1][_s] = __builtin_bit_cast(bf16x8, w1); } } while (0)
#define AT_PV(_sb) do { _Pragma("unroll") for (int _s = 0; _s < 2; ++_s) { \
            O0 = __builtin_amdgcn_mfma_f32_32x32x16_bf16(vf0[_s], pf[_sb][_s], O0, 0, 0, 0); O1 = __builtin_amdgcn_mfma_f32_32x32x16_bf16(vf1[_s], pf[_sb][_s], O1, 0, 0, 0); } } while (0)
#define AT_SB() __builtin_amdgcn_sched_barrier(0)
#define AT_STEP(i_, P0, P1, N0, N1) do { const int _si = (i_); \
        const int slot1 = slot == 2 ? 0 : slot + 1, slot2 = slot1 == 2 ? 0 : slot1 + 1; \
        AT_KLOAD(slot1, 0); \
        AT_MASKMAX(_si, P0, P1); \
        AT_SB(); AT_QK0(N0, N1); AT_SB(); \
        AT_EXP(P0); \
        AT_SB(); AT_QKSTEP(1, N0, N1); AT_SB(); AT_KLOAD(slot1, 1); AT_SB(); \
        if (_si + 2 < nt) AT_STORE(slot2, kA, vA);     \
        if (_si + 3 < nt) AT_LOAD(_si + 3, kA, vA); \
        AT_SB(); \
        AT_EXP(P1); \
        AT_SB(); AT_QKSTEP(2, N0, N1); AT_SB(); \
        AT_VLOAD(slot, 0); \
        AT_FIN(P0, P1); \
        AT_SB(); AT_QKSTEP(3, N0, N1); AT_SB(); \
        AT_PV(0); AT_SB(); AT_VLOAD(slot, 1); AT_PV(1); \
        __syncthreads(); \
        slot = slot1; } while (0)
#define AT_TAIL(P0, P1) do { AT_VLOAD(slot, 0); AT_MASKMAX(nt - 1, P0, P1); AT_EXP(P0); AT_EXP(P1); AT_FIN(P0, P1); AT_PV(0); AT_SB(); AT_VLOAD(slot, 1); AT_PV(1); } while (0)
        f32x16 p0, p1, n0, n1, negm; bf16x8 ka[2], kc[2], vf0[2], vf1[2], pf[2][2];
#pragma unroll
        for (int r = 0; r < 16; ++r) negm[r] = 0.f;
        { u32x4 kB, vB;
          AT_LOAD(0, kA, vA); AT_LOAD(1, kB, vB);
          __syncthreads();
          if (MIX == 0 && lat) { for (int i = tid; i < 465; i += 512) rpbL[i] = rpb[h * 465 + i] * LOG2E; }
          AT_STORE(0, kA, vA); AT_STORE(1, kB, vB); }
        AT_LOAD(2, kA, vA);
        __syncthreads();
        { AT_KLOAD(0, 0); AT_QK0(p0, p1); AT_QKSTEP(1, p0, p1); AT_SB(); AT_KLOAD(0, 1); AT_QKSTEP(2, p0, p1); AT_QKSTEP(3, p0, p1); }
        int slot = 0;
        int i = 0;
        for (; i + 2 < nt; i += 2) {
            AT_STEP(i, p0, p1, n0, n1);
            AT_STEP(i + 1, n0, n1, p0, p1);
        }
        if (i + 1 < nt) { AT_STEP(i, p0, p1, n0, n1); p0 = n0; p1 = n1; }
        AT_TAIL(p0, p1);
#undef AT_LOAD
#undef AT_STORE
        if (MIX == 1 && hi == 0) l += __builtin_amdgcn_exp2f(sink[h] * LOG2E - mhat);
        const float lt_ = l + __shfl_xor(l, 32), inv = 1.f / lt_;
        { LAS unsigned char* stg = lds + AT_OST + wid * (32 * 144);
#pragma unroll
          for (int rg = 0; rg < 4; ++rg) {
              u32x2 w0, w1;
              w0.x = cvtpk(O0[4 * rg + 0] * inv, O0[4 * rg + 1] * inv); w0.y = cvtpk(O0[4 * rg + 2] * inv, O0[4 * rg + 3] * inv);
              w1.x = cvtpk(O1[4 * rg + 0] * inv, O1[4 * rg + 1] * inv); w1.y = cvtpk(O1[4 * rg + 2] * inv, O1[4 * rg + 3] * inv);
              *(LAS u32x2*)(stg + ql * 144 + (8 * rg + 4 * hi) * 2) = w0; *(LAS u32x2*)(stg + ql * 144 + (32 + 8 * rg + 4 * hi) * 2) = w1;
          }
          asm volatile("s_waitcnt lgkmcnt(0)" ::: "memory");
          bf16_t* ob = O + (qrow0 + 32 * wid) * 1024 + h * 64;
#pragma unroll
          for (int i4 = 0; i4 < 4; ++i4) { const int row = i4 * 8 + (lane >> 3), ch = lane & 7; const u32x4 v = *(const LAS u32x4*)(stg + row * 144 + ch * 16); *(u32x4*)(ob + (size_t)row * 1024 + ch * 8) = v; }
          asm volatile("s_waitcnt lgkmcnt(0)" ::: "memory");
        }
    }
}

__global__ void __launch_bounds__(512, 2) hybrid_fwd(Params Pbyval) {
    extern __shared__ __attribute__((aligned(16))) unsigned char lds_raw[];
    LAS unsigned char* lds = (LAS unsigned char*)lds_raw;
    cg::grid_group grid = cg::this_grid();
    const KP Pk = (KP)__builtin_amdgcn_kernarg_segment_ptr();
#define PARAMS() ({ KP _p = Pk; asm volatile("" : "+s"(_p)); _p; })
    { volatile LAS unsigned* st0 = (volatile LAS unsigned*)(lds + 131072 + 1024); if (threadIdx.x < 2) st0[threadIdx.x] = 0u; }
    __syncthreads();
    XcdBarrier bar = xcd_barrier_post((unsigned*)(Pk->ws + WS_BAR), (volatile LAS unsigned*)(lds + 131072 + 1024));
    if (Pk->ph_lo < 0) grid.sync();
    int ph = 0;
#define PH_BEGIN { KP q = PARAMS(); if (ph >= q->ph_lo && ph < q->ph_hi) { unsigned char* const ws = q->ws; bf16_t* const X = (bf16_t*)(ws + WS_X); (void)ws; (void)X;
#define PH_END } } { KP q2 = PARAMS(); const bool _in = ph >= q2->ph_lo && ph + 1 < q2->ph_hi; ++ph; if (_in) { for (int rs = 0; rs < REP_SYNC; ++rs) xcd_barrier(bar); } }
#define PH_END_IF(cnd) } } { KP q2 = PARAMS(); const bool _in = ph >= q2->ph_lo && ph + 1 < q2->ph_hi; ++ph; if (_in && (cnd)) { for (int rs = 0; rs < REP_SYNC; ++rs) xcd_barrier(bar); } }

    PH_BEGIN
        const int tid = opaque_tid(), lane = tid & 63, wave = tid >> 6; const int bid = opaque_bid();
        const int gw = bid * 8 + wave, ngw = gridDim.x * 8;
        for (int rep = 0; rep < REP_P0; ++rep) {
        mods_phase(q, lds);
        LAS float* scr = (LAS float*)(lds + wave * 16384);
#pragma unroll 1
        for (int l = 0; l < 4; ++l) {
            transpose_matrix(q->in[14] + (size_t)l * DM * DM, DM, DM, (bf16_t*)(ws + WS_WO + l * 2 * MiB), scr, gw, ngw, lane);
            transpose_matrix(q->in[15] + (size_t)l * DM * DFF, DM, DFF, (bf16_t*)(ws + WS_W1 + l * 8 * MiB), scr, gw, ngw, lane);
            transpose_matrix(q->in[17] + (size_t)l * DFF * DM, DFF, DM, (bf16_t*)(ws + WS_W2 + l * 8 * MiB), scr, gw, ngw, lane);
        }
#pragma unroll 1
        for (int j = 0; j < 2; ++j) transpose_matrix(q->in[19] + (size_t)j * DM * 3072, DM, 3072, (bf16_t*)(ws + WS_QKVA + j * 6 * MiB), scr, gw, ngw, lane);
        transpose_matrix(q->in[21], DM, 1536, (bf16_t*)(ws + WS_QKVB), scr, gw, ngw, lane);
        transpose_matrix(q->in[23], DM, 1536, (bf16_t*)(ws + WS_QKVC), scr, gw, ngw, lane);
        const size_t gt = (size_t)bid * 512 + tid, ngt = (size_t)gridDim.x * 512;
        convert_array(q->in[2], (bf16_t*)(ws + WS_CKA), 8388608 / 4, gt, ngt);
        convert_array(q->in[3], (bf16_t*)(ws + WS_CVA), 8388608 / 4, gt, ngt);
        convert_array(q->in[4], (bf16_t*)(ws + WS_CKB), 1048576 / 4, gt, ngt);
        convert_array(q->in[5], (bf16_t*)(ws + WS_CVB), 1048576 / 4, gt, ngt);
        convert_array(q->in[6], (bf16_t*)(ws + WS_CKC), 1048576 / 4, gt, ngt);
        convert_array(q->in[7], (bf16_t*)(ws + WS_CVC), 1048576 / 4, gt, ngt);
        { f32x4* rz = (f32x4*)(ws + WS_ROWSQ); for (size_t i = gt; i < (size_t)9 * NTOK / 4; i += ngt) rz[i] = (f32x4){0.f, 0.f, 0.f, 0.f}; }
        }
    PH_END
    PH_BEGIN
        shw_phase(q, lds);
        xin_phase(q->in[0], q->in[1], X, (bf16_t*)(ws + WS_H), (float*)(ws + WS_ROWSQ), q->in[12], (const float*)(ws + WS_MODS));
    PH_END

#pragma unroll 1
    for (int l = 0; l < 4; ++l) {
        PH_BEGIN
            const int mix = l % 3, j = l / 3; const int nkv = mix == 0 ? 16 : 4, nk = nkv * 64, nqkv = 1024 + 2 * nk;
            const bf16_t* Wt = (const bf16_t*)(ws + (mix == 0 ? WS_QKVA + (size_t)j * 6 * MiB : (mix == 1 ? WS_QKVB : WS_QKVC)));
            float* ko = q->out + (mix == 0 ? OUT_KA : (mix == 1 ? OUT_KB : OUT_KC)); float* vo = q->out + (mix == 0 ? OUT_VA : (mix == 1 ? OUT_VB : OUT_VC));
            const int c = opaque_bid(); const int nwg = (NTOK / 256) * (nqkv / 256), full = (nwg / 256) * 256;
            pg8::Gemm g{(const bf16_t*)(ws + WS_H), Wt, NTOK, nqkv, DM}; pg8::StaticOrder S; S.init(NTOK, nqkv, gridDim.x, c);
            pg8::EpiQKV E{(bf16_t*)(ws + WS_QKV), nqkv, nk, ko, vo, mix == 0 ? 2 : 1, mix == 0 ? j : 0, (const float*)(ws + WS_ROWSQ) + (size_t)(2 * l) * NTOK, (const float*)(ws + WS_SHW) + (size_t)(2 * l) * 9 * 4096, 0, 0};
            if (gridDim.x == 256) {
                S.lim = full;
                pg8::gemm_phase<pg8::EpiQKV, pg8::StaticOrder, true, true>(lds, g, S, E);
                const int pr = (c & 7) + 8 * (c >> 4), hf = (c >> 3) & 1;
                if (full + pr < nwg) {
                    pg8::OneUnit S1; S.map(full + pr, S1.u); pg8::Gemm g2{(const bf16_t*)(ws + WS_H) + (size_t)hf * 128 * DM, Wt, NTOK, nqkv, DM};
                    pg8::EpiQKV E2 = E; E2.halfm = 1; E2.rowoff = hf * 128;
                    pg8::gemm_phase<pg8::EpiQKV, pg8::OneUnit, true, true, true>(lds, g2, S1, E2);
                }
            } else pg8::gemm_phase<pg8::EpiQKV, pg8::StaticOrder, true, true>(lds, g, S, E);
        PH_END
        PH_BEGIN
            const int mix = l % 3;
            if (mix == 1) qkfix_phase<1>((bf16_t*)(ws + WS_QKV), nullptr, nullptr, nullptr);
            else if (mix == 2) qkfix_phase<2>((bf16_t*)(ws + WS_QKV), q->in[24], q->in[25], q->out + OUT_KC);
        PH_END_IF((l % 3) != 0)
        PH_BEGIN
            const int mix = l % 3, j = l / 3;
            const bf16_t* QKV = (const bf16_t*)(ws + WS_QKV); bf16_t* AO = (bf16_t*)(ws + WS_O);
            for (int rep = 0; rep < REP_ATTN; ++rep)
            if (mix == 0) attn_phase<0>(lds, QKV, 3072, 16, (const bf16_t*)(ws + WS_CKA) + (size_t)j * 512 * 1024, (const bf16_t*)(ws + WS_CVA) + (size_t)j * 512 * 1024, (size_t)2 * 512 * 1024, q->in[20] + (size_t)j * 16 * 465, nullptr, nullptr, AO);
            else if (mix == 1) attn_phase<1>(lds, QKV, 1536, 4, (const bf16_t*)(ws + WS_CKB), (const bf16_t*)(ws + WS_CVB), (size_t)512 * 256, nullptr, q->in[22], nullptr, AO);
            else attn_phase<2>(lds, QKV, 1536, 4, (const bf16_t*)(ws + WS_CKC), (const bf16_t*)(ws + WS_CVC), (size_t)512 * 256, nullptr, nullptr, q->in[24], AO);
        PH_END
        PH_BEGIN
            const bf16_t* A_ = (const bf16_t*)(ws + WS_O); const bf16_t* B_ = (const bf16_t*)(ws + WS_WO + (size_t)l * 2 * MiB);
            pg8::EpiResGate E{X, (const float*)(ws + WS_MODS) + (size_t)l * 9 * 6144 + 2 * 1024, nullptr, (float*)(ws + WS_ROWSQ) + (size_t)(2 * l + 1) * NTOK, (bf16_t*)(ws + WS_H), q->in[13] + l * DM, (const float*)(ws + WS_MODS) + (size_t)l * 9 * 6144 + 4 * 1024, 0, 0};
            const int c = opaque_bid();
            if (gridDim.x == 256) {
                pg8::StaticOrder so; so.init(NTOK, DM, 256, c);
                { pg8::OneUnit S; so.map(c, S.u); pg8::Gemm g{A_, B_, NTOK, DM, DM};
                  pg8::gemm_phase<pg8::EpiResGate, pg8::OneUnit, true, true>(lds, g, S, E); }
                { const int pr = (c & 7) + 8 * (c >> 4), hf = (c >> 3) & 1;
                  pg8::OneUnit S; so.map(256 + pr, S.u); pg8::Gemm g{A_ + (size_t)hf * 128 * DM, B_, NTOK, DM, DM};
                  pg8::EpiResGate E2 = E; E2.halfm = 1; E2.rowoff = hf * 128;
                  pg8::gemm_phase<pg8::EpiResGate, pg8::OneUnit, true, true, true>(lds, g, S, E2); }
            } else {
                pg8::Gemm g{A_, B_, NTOK, DM, DM}; pg8::StaticOrder S; S.init(NTOK, DM, gridDim.x, c);
                pg8::gemm_phase<pg8::EpiResGate, pg8::StaticOrder, true, true>(lds, g, S, E);
            }
        PH_END
        PH_BEGIN
            pg8::Gemm g{(const bf16_t*)(ws + WS_H), (const bf16_t*)(ws + WS_W1 + (size_t)l * 8 * MiB), NTOK, DFF, DM}; pg8::StaticOrder S; S.init(NTOK, DFF, gridDim.x, opaque_bid());
            pg8::EpiSqRelu E{(bf16_t*)(ws + WS_U), DFF, (const float*)(ws + WS_ROWSQ) + (size_t)(2 * l + 1) * NTOK, (const float*)(ws + WS_SHW) + (size_t)(2 * l + 1) * 9 * 4096};
            for (int rep = 0; rep < REP_GEMM; ++rep) pg8::gemm_phase<pg8::EpiSqRelu, pg8::StaticOrder, true, true>(lds, g, S, E);
        PH_END
        PH_BEGIN
            const bf16_t* A_ = (const bf16_t*)(ws + WS_U); const bf16_t* B_ = (const bf16_t*)(ws + WS_W2 + (size_t)l * 8 * MiB);
            pg8::EpiResGate E{X, (const float*)(ws + WS_MODS) + (size_t)l * 9 * 6144 + 5 * 1024, q->in[18] + l * DM, (float*)(ws + WS_ROWSQ) + (size_t)(2 * l + 2) * NTOK, l < 3 ? (bf16_t*)(ws + WS_H) : nullptr, q->in[12] + (l < 3 ? l + 1 : 0) * DM, (const float*)(ws + WS_MODS) + (size_t)(l < 3 ? l + 1 : 0) * 9 * 6144 + 1 * 1024, 0, 0};
            const int c = opaque_bid();
            if (gridDim.x == 256) {
                pg8::StaticOrder so; so.init(NTOK, DM, 256, c);
                { pg8::OneUnit S; so.map(c, S.u); pg8::Gemm g{A_, B_, NTOK, DM, DFF};
                  pg8::gemm_phase<pg8::EpiResGate, pg8::OneUnit, true, true>(lds, g, S, E); }
                { const int pr = (c & 7) + 8 * (c >> 4), hf = (c >> 3) & 1;
                  pg8::OneUnit S; so.map(256 + pr, S.u); pg8::Gemm g{A_ + (size_t)hf * 128 * DFF, B_, NTOK, DM, DFF};
                  pg8::EpiResGate E2 = E; E2.halfm = 1; E2.rowoff = hf * 128;
                  pg8::gemm_phase<pg8::EpiResGate, pg8::OneUnit, true, true, true>(lds, g, S, E2); }
            } else {
                pg8::Gemm g{A_, B_, NTOK, DM, DFF}; pg8::StaticOrder S; S.init(NTOK, DM, gridDim.x, c);
                pg8::gemm_phase<pg8::EpiResGate, pg8::StaticOrder, true, true>(lds, g, S, E);
            }
        PH_END
    }
    PH_BEGIN
        final_norm_phase(X, q->out + OUT_X, q->in[26], (const float*)(ws + WS_ROWSQ) + (size_t)8 * NTOK);
    PH_END
}
constexpr int N_PHASES = 2 + 4 * 6 + 1;

extern "C" void kernel_launch(void* const* d_in, const int* in_sizes, int n_in, void* d_out, int out_size, void* d_ws, size_t ws_size, hipStream_t stream) {
    static int grid = 0;
    if (grid == 0) {
        if (n_in != 27 || out_size != 67108864 || ws_size < WS_END) { fprintf(stderr, "kernel_launch: unexpected shapes n_in %d out %d ws %zu\n", n_in, out_size, ws_size); grid = -1; return; }
        int dev = 0, cus = 0, per_cu = 0;
        (void)hipGetDevice(&dev); (void)hipDeviceGetAttribute(&cus, hipDeviceAttributeMultiprocessorCount, dev);
        (void)hipFuncSetAttribute((const void*)hybrid_fwd, hipFuncAttributeMaxDynamicSharedMemorySize, LDS_BYTES);
        (void)hipOccupancyMaxActiveBlocksPerMultiprocessor(&per_cu, (const void*)hybrid_fwd, 512, LDS_BYTES);
        if (per_cu < 1) { fprintf(stderr, "kernel_launch: occupancy query says %d blocks per CU\n", per_cu); per_cu = 1; }
        (void)hipGetLastError();
        grid = cus;
    }
    if (grid < 0) return;
    (void)hipMemsetAsync((unsigned char*)d_ws + WS_BAR, 0, XCD_BAR_WORDS * 4, stream);
    Params p{};
    for (int i = 0; i < 27; ++i) p.in[i] = (const float*)d_in[i];
    p.out = (float*)d_out; p.ws = (unsigned char*)d_ws;
#ifdef MK_MULTI
    for (int ph = 0; ph < N_PHASES; ++ph) { p.ph_lo = ph; p.ph_hi = ph + 1; hipLaunchKernelGGL(hybrid_fwd, dim3(grid), dim3(512), LDS_BYTES, stream, p); }
#else
    p.ph_lo = 0; p.ph_hi = N_PHASES;
    void* args[] = {&p};
    hipError_t e = hipLaunchCooperativeKernel((const void*)hybrid_fwd, dim3(grid), dim3(512), args, LDS_BYTES, stream);
    if (e != hipSuccess) fprintf(stderr, "cooperative launch failed: %s (grid %d)\n", hipGetErrorString(e), grid);
#endif
}
```
